# Optimizing an MI355X kernel written in HIP

```python
import math
import jax, jax.numpy as jnp
from jax import lax
import numpy as np

D_MODEL = 1024
BATCH = 16
SEQ = 2048
DEPTH = 2
DEC_BATCH = 8
DEC_SEQ = 4096
PAST_LEN = 128

HEAD_DIM = 64
ATT_HEADS = 6
ATT_W = ATT_HEADS * HEAD_DIM
DILATION_PATTERNS = ((128, 1), (512, 4), (2048, 16))
ATT_BLOCK = 64
RET_HEADS = 4
RET_HEAD_DIM = 96
RET_W = RET_HEADS * RET_HEAD_DIM
RET_CHUNK = 128
CONV_W = D_MODEL - ATT_W - RET_W
CONV_WIDTH = 3
MIX_W = ATT_W + RET_W + CONV_W
MIX_IN_W = 3 * ATT_W + 4 * RET_W + 3 * CONV_W
D_FF = 2816
NORM_EPS = 1e-6
NEG_INF = -1e30

kernel_name = "hybrid_bidir_encoder_dilated_retention_shortconv"


def rmsnorm(x, g):
    xf = x.astype(jnp.float32)
    y = xf * lax.rsqrt(jnp.mean(xf * xf, axis=-1, keepdims=True) + NORM_EPS) * g.astype(jnp.float32)
    return y.astype(x.dtype)


def swiglu(x, w_gate, w_up, w_down):
    return (jax.nn.silu(x @ w_gate) * (x @ w_up)) @ w_down


def _alibi_slope_list(n):
    def pow2(m):
        start = 2.0 ** (-8.0 / m)
        return [start ** (i + 1) for i in range(m)]
    if math.log2(n).is_integer():
        return pow2(n)
    c = 2 ** math.floor(math.log2(n))
    return pow2(c) + _alibi_slope_list(2 * c)[0::2][: n - c]


def alibi_slopes(n):
    return jnp.array(_alibi_slope_list(n), dtype=jnp.float32)


def dilated_window_attention(q, k, v, slopes, window, dilation):
    B, S, H, dh = q.shape
    half = window // (2 * dilation)
    L = S // dilation
    nb = -(-L // ATT_BLOCK)
    Lp = nb * ATT_BLOCK

    def to_sub(t):
        t = t.reshape(B, L, dilation, H, dh).transpose(0, 2, 3, 1, 4)
        return jnp.pad(t, ((0, 0), (0, 0), (0, 0), (0, Lp - L), (0, 0)))

    def windows(t):
        tp = jnp.pad(t, ((0, 0), (0, 0), (0, 0), (ATT_BLOCK, ATT_BLOCK), (0, 0)))
        tb = tp.reshape(B, dilation, H, nb + 2, ATT_BLOCK, dh)
        return jnp.concatenate([tb[:, :, :, :-2], tb[:, :, :, 1:-1], tb[:, :, :, 2:]], axis=4)

    qb = to_sub(q).reshape(B, dilation, H, nb, ATT_BLOCK, dh)
    kw = windows(to_sub(k))
    vw = windows(to_sub(v))
    s = jnp.einsum("brhnqd,brhnkd->brhnqk", qb, kw, preferred_element_type=jnp.float32) * (dh ** -0.5)

    qi = jnp.arange(nb)[:, None, None] * ATT_BLOCK + jnp.arange(ATT_BLOCK)[None, :, None]
    kj = (jnp.arange(nb)[:, None, None] - 1) * ATT_BLOCK + jnp.arange(3 * ATT_BLOCK)[None, None, :]
    rel = jnp.abs(qi - kj)
    valid = (rel <= half) & (kj >= 0) & (kj < L)
    bias = -slopes[:, None, None, None] * (dilation * rel).astype(jnp.float32)[None]
    s = jnp.where(valid, s + bias, NEG_INF)

    m = jnp.max(s, axis=-1, keepdims=True)
    p = jnp.exp(s - m)
    den = jnp.sum(p, axis=-1, keepdims=True)
    o = jnp.einsum("brhnqk,brhnkd->brhnqd", p, vw.astype(jnp.float32)) / den
    lse = (m + jnp.log(den))[..., 0]

    o = o.reshape(B, dilation, H, Lp, dh)[:, :, :, :L].transpose(0, 3, 1, 2, 4).reshape(B, S, H, dh)
    lse = lse.reshape(B, dilation, H, Lp)[:, :, :, :L].transpose(0, 3, 1, 2).reshape(B, S, H)
    return o, lse


def retention_one_direction(q, k, v, log_gamma, include_diag):
    B, H, S, dk = q.shape
    dv = v.shape[-1]
    C = RET_CHUNK
    n = S // C
    qc = q.reshape(B, H, n, C, dk)
    kc = k.reshape(B, H, n, C, dk)
    vc = v.reshape(B, H, n, C, dv)
    pos = jnp.arange(C, dtype=jnp.float32)
    rel = pos[:, None] - pos[None, :]
    mask = (rel >= 0) if include_diag else (rel > 0)
    decay = jnp.where(mask, jnp.exp(log_gamma[:, None, None] * jnp.maximum(rel, 0.0)), 0.0)
    scores = jnp.einsum("bhnqd,bhnkd->bhnqk", qc, kc) * decay[None, :, None]
    o_intra = jnp.einsum("bhnqk,bhnke->bhnqe", scores, vc)

    k_w = jnp.exp(log_gamma[:, None] * (C - 1 - pos))
    kv = jnp.einsum("bhnkd,bhnke->nbhde", kc * k_w[None, :, None, :, None], vc)
    g_chunk = jnp.exp(log_gamma * C)[None, :, None, None]

    def step(state, kv_i):
        return state * g_chunk + kv_i, state

    _, states = lax.scan(step, jnp.zeros((B, H, dk, dv), jnp.float32), kv)
    q_w = jnp.exp(log_gamma[:, None] * (pos + 1.0))
    o_cross = jnp.einsum("bhnqd,nbhde->bhnqe", qc * q_w[None, :, None, :, None], states)
    return (o_intra + o_cross).reshape(B, H, S, dv)


def hybrid_mixer(h, w_in, w_out, conv_w, ret_decay_logit):
    B, S, _ = h.shape
    z = h @ w_in
    sizes = [ATT_W] * 3 + [RET_W] * 4 + [CONV_W] * 3
    q_a, k_a, v_a, q_r, k_r, v_r, g_r, b_c, c_c, u_c = jnp.split(z, np.cumsum(sizes)[:-1].tolist(), axis=-1)

    qh = q_a.reshape(B, S, ATT_HEADS, HEAD_DIM)
    kh = k_a.reshape(B, S, ATT_HEADS, HEAD_DIM)
    vh = v_a.reshape(B, S, ATT_HEADS, HEAD_DIM)
    slopes = alibi_slopes(ATT_HEADS)
    outs, lses = [], []
    for window, dilation in DILATION_PATTERNS:
        o, l = dilated_window_attention(qh, kh, vh, slopes, window, dilation)
        outs.append(o)
        lses.append(l)
    wts = jax.nn.softmax(jnp.stack(lses, axis=0), axis=0)
    att = jnp.sum(wts[..., None] * jnp.stack(outs, axis=0), axis=0).reshape(B, S, ATT_W).astype(h.dtype)

    def rh(t):
        return t.reshape(B, S, RET_HEADS, RET_HEAD_DIM).transpose(0, 2, 1, 3).astype(jnp.float32)
    qr, kr, vr = rh(q_r), rh(k_r) * (RET_HEAD_DIM ** -0.5), rh(v_r)
    log_gamma = jax.nn.log_sigmoid(ret_decay_logit.astype(jnp.float32))
    o_fwd = retention_one_direction(qr, kr, vr, log_gamma[0], True)
    o_bwd = jnp.flip(retention_one_direction(jnp.flip(qr, 2), jnp.flip(kr, 2), jnp.flip(vr, 2), log_gamma[1], False), 2)
    o = o_fwd + o_bwd
    mu = jnp.mean(o, axis=-1, keepdims=True)
    var = jnp.mean(jnp.square(o - mu), axis=-1, keepdims=True)
    o = (o - mu) * lax.rsqrt(var + NORM_EPS)
    ret = o.transpose(0, 2, 1, 3).reshape(B, S, RET_W).astype(h.dtype) * jax.nn.silu(g_r)

    u = c_c * u_c
    conv = lax.conv_general_dilated(u, conv_w[:, None, :], window_strides=(1,),
                                    padding=[(CONV_WIDTH // 2, CONV_WIDTH // 2)],
                                    dimension_numbers=("NWC", "WIO", "NWC"),
                                    feature_group_count=CONV_W)
    cv = b_c * conv

    return jnp.concatenate([att, ret, cv], axis=-1) @ w_out


def trunk(x, norm_gain, ffn1_w_gate, ffn1_w_up, ffn1_w_down, w_mix_in, conv_w,
          ret_decay_logit, w_mix_out, ffn2_w_gate, ffn2_w_up, ffn2_w_down):
    for l in range(DEPTH):
        g = norm_gain[l]
        h = swiglu(rmsnorm(x, g[0]), ffn1_w_gate[l], ffn1_w_up[l], ffn1_w_down[l])
        x = x + 0.5 * rmsnorm(h, g[1])
        h = hybrid_mixer(rmsnorm(x, g[2]), w_mix_in[l], w_mix_out[l], conv_w[l], ret_decay_logit[l])
        x = x + rmsnorm(h, g[3])
        h = swiglu(rmsnorm(x, g[4]), ffn2_w_gate[l], ffn2_w_up[l], ffn2_w_down[l])
        x = x + 0.5 * rmsnorm(h, g[5])
    return x


def setup_inputs(seed: int = 0) -> dict:
    key = jax.random.key(seed)
    ks = jax.random.split(key, 16)

    def nrm(k, shape, scale):
        return jax.random.normal(k, shape, jnp.float32) * scale

    base_logit = jnp.log(jnp.exp2(5.0 + jnp.arange(RET_HEADS, dtype=jnp.float32)) - 1.0)
    return {
        "x_prompt": nrm(ks[0], (BATCH, SEQ, D_MODEL), 1.0),
        "x_sample": nrm(ks[1], (DEC_BATCH, DEC_SEQ, D_MODEL), 1.0),
        "norm_gain": 1.0 + nrm(ks[2], (DEPTH, 6, D_MODEL), 0.02),
        "ffn1_w_gate": nrm(ks[3], (DEPTH, D_MODEL, D_FF), D_MODEL ** -0.5),
        "ffn1_w_up": nrm(ks[4], (DEPTH, D_MODEL, D_FF), D_MODEL ** -0.5),
        "ffn1_w_down": nrm(ks[5], (DEPTH, D_FF, D_MODEL), D_FF ** -0.5),
        "w_mix_in": nrm(ks[6], (DEPTH, D_MODEL, MIX_IN_W), D_MODEL ** -0.5),
        "conv_w": nrm(ks[7], (DEPTH, CONV_WIDTH, CONV_W), CONV_WIDTH ** -0.5),
        "ret_decay_logit": base_logit[None, None, :] + nrm(ks[8], (DEPTH, 2, RET_HEADS), 0.1),
        "w_mix_out": nrm(ks[9], (DEPTH, MIX_W, D_MODEL), MIX_W ** -0.5),
        "ffn2_w_gate": nrm(ks[10], (DEPTH, D_MODEL, D_FF), D_MODEL ** -0.5),
        "ffn2_w_up": nrm(ks[11], (DEPTH, D_MODEL, D_FF), D_MODEL ** -0.5),
        "ffn2_w_down": nrm(ks[12], (DEPTH, D_FF, D_MODEL), D_FF ** -0.5),
    }


def reference(x_prompt, x_sample, norm_gain, ffn1_w_gate, ffn1_w_up, ffn1_w_down, w_mix_in, conv_w,
              ret_decay_logit, w_mix_out, ffn2_w_gate, ffn2_w_up, ffn2_w_down):
    y_prompt = trunk(x_prompt, norm_gain, ffn1_w_gate, ffn1_w_up, ffn1_w_down, w_mix_in, conv_w,
                     ret_decay_logit, w_mix_out, ffn2_w_gate, ffn2_w_up, ffn2_w_down)
    y_sample = trunk(x_sample, norm_gain, ffn1_w_gate, ffn1_w_up, ffn1_w_down, w_mix_in, conv_w,
                     ret_decay_logit, w_mix_out, ffn2_w_gate, ffn2_w_up, ffn2_w_down)
    return (y_prompt, y_sample)
```

```cpp
#ifndef REP_MASK
#define REP_MASK 0
#endif
#define NREP(k) ((((REP_MASK) >> (k)) & 1) + 1)
#include <hip/hip_runtime.h>
#include <hip/hip_cooperative_groups.h>
#include <cstdio>
#include <cstdint>
namespace cg = cooperative_groups;

#define LAS __attribute__((address_space(3)))
typedef unsigned short bf16_t;
typedef short bf16x8 __attribute__((ext_vector_type(8)));
typedef short bf16x4 __attribute__((ext_vector_type(4)));
typedef float f32x4 __attribute__((ext_vector_type(4)));
typedef unsigned u32x4 __attribute__((ext_vector_type(4)));
typedef unsigned u32x2 __attribute__((ext_vector_type(2)));

constexpr int D = 1024, FF = 2816, NUP = 5632, NIN = 3456, NINP = 3584, TH = 32768, ZS = 3456, DEPTH = 2;
constexpr float EPS = 1e-6f;
constexpr float LOG2E = 1.4426950408889634f;
constexpr size_t ZA_OFF = 0, ZR_OFF = (size_t)TH * 1152, ZC_OFF = (size_t)TH * 2688;
constexpr size_t L_UP1 = 0, L_DN1 = 5767168, L_IN = 8650752, L_OUT = 12320768, L_UP2 = 13369344, L_DN2 = 19136512, L_ELEMS = 22020096;
constexpr size_t WS_W = 0, WS_XA = 2 * L_ELEMS * 2, WS_OB = WS_XA + (size_t)TH * D * 2, WS_BIG = WS_OB + (size_t)TH * D * 2,
                 WS_ST = WS_BIG + (size_t)TH * ZS * 2, WS_P2 = WS_ST + (size_t)256 * 4 * 2 * 9216 * 2, WS_END = WS_P2 + (size_t)TH * 384 * 2;
constexpr size_t WS_BAR = WS_END, WS_RS = WS_BAR + 16384, WS_TOTAL = WS_RS + (size_t)TH * 4;
constexpr size_t OB_LSE_OFF = (size_t)2 * TH * 384 * 2;
constexpr int LDS_STAGE = 131072, LDS_BYTES = LDS_STAGE + 256;

__device__ __forceinline__ unsigned cvt_pk_bf16(float lo, float hi) { unsigned r; asm volatile("v_cvt_pk_bf16_f32 %0, %1, %2" : "=v"(r) : "v"(lo), "v"(hi)); return r; }
__device__ __forceinline__ float bf_lo(unsigned w) { return __uint_as_float(w << 16); }
__device__ __forceinline__ float bf_hi(unsigned w) { return __uint_as_float(w & 0xffff0000u); }
__device__ __forceinline__ float wave_sum(float v) {
#pragma unroll
    for (int o = 1; o < 64; o <<= 1) v += __shfl_xor(v, o);
    return v;
}
__device__ __forceinline__ float fexp2(float x) { return __builtin_amdgcn_exp2f(x); }
template <int O> __device__ __forceinline__ float shx(float v, int lane) {
    if constexpr (O < 32) return __int_as_float(__builtin_amdgcn_ds_swizzle(__float_as_int(v), 0x1f | (O << 10)));
    else return __int_as_float(__builtin_amdgcn_ds_bpermute((lane ^ 32) << 2, __float_as_int(v)));
}
__device__ __forceinline__ float shx(float v, int o, int lane) { return __int_as_float(__builtin_amdgcn_ds_bpermute((lane ^ o) << 2, __float_as_int(v))); }

namespace pg8 {
constexpr int BM = 256, BK = 64, HALF = 128, HTB = HALF * BK * 2, STAGE_BYTES = 8 * HTB, NXCD = 8, WGM = 8;
__host__ __device__ __forceinline__ int lds_byte(int r, int c) { const int st = (r >> 4) * 2 + (c >> 5), rr = r & 15, cc = c & 31, ob = rr * 64 + cc * 2; return st * 1024 + (ob ^ (((ob >> 9) & 1) << 5)); }
__host__ __device__ __forceinline__ void stage_rc(int b, int& R, int& C) { const int st = b / 1024, sb = b % 1024, swz = sb ^ (((sb >> 9) & 1) << 5); R = (st >> 1) * 16 + swz / 64; C = (st & 1) * 32 + (swz % 64) / 2; }
__host__ __device__ __forceinline__ int perm32(int rho) { const int n = rho >> 4, i = rho & 15; return 8 * (i >> 2) + 4 * n + (i & 3); }

struct Unit { int pm, pn; };
struct Gemm { const bf16_t* A; const bf16_t* Bt; int M, N, K, lda; };

struct StaticOrder {
    int nM, nN, nwg, G, c;
    __device__ void init(int M, int N, int G_, int c_) { nM = M / BM; nN = N / BM; nwg = nM * nN; G = G_; c = c_; }
    __device__ bool next(int i, Unit& u) const {
        const long L = (long)i * G + c; if (L >= nwg) return false;
        int wgid = (int)L; { const int q = nwg / NXCD, r = nwg % NXCD, xcd = wgid % NXCD, off = wgid / NXCD; wgid = (xcd < r ? xcd * (q + 1) : r * (q + 1) + (xcd - r) * q) + off; }
        const int nig = WGM * nN, gid = wgid / nig, fm = gid * WGM, gsz = (nM - fm) < WGM ? (nM - fm) : WGM;
        u.pm = fm + ((wgid % nig) % gsz); u.pn = (wgid % nig) / gsz; return true;
    }
};

struct EpiSwiglu {
    static constexpr bool PERM = true;
    bf16_t* H; int ldh;
    __device__ __forceinline__ void operator()(const f32x4 (&acc)[2][2][4][2], const Unit& u, int wr, int wc, int fr, int fq) const {
        const int row0 = u.pm * BM + wr * 64 + fr, col0 = u.pn * HALF + wc * 32 + 8 * fq;
#pragma unroll
        for (int ai = 0; ai < 2; ++ai)
#pragma unroll
            for (int m = 0; m < 4; ++m) {
                bf16_t* p = H + (size_t)(row0 + ai * HALF + m * 16) * ldh + col0;
                float v[8];
#pragma unroll
                for (int n = 0; n < 2; ++n)
#pragma unroll
                    for (int j = 0; j < 4; ++j) { const float g = acc[ai][0][m][n][j], up = acc[ai][1][m][n][j];
                        v[n * 4 + j] = g * __builtin_amdgcn_rcpf(1.0f + __expf(-g)) * up; }
                u32x4 w; w.x = cvt_pk_bf16(v[0], v[1]); w.y = cvt_pk_bf16(v[2], v[3]); w.z = cvt_pk_bf16(v[4], v[5]); w.w = cvt_pk_bf16(v[6], v[7]);
                *(u32x4*)p = w;
            }
    }
};
struct EpiStore {
    static constexpr bool PERM = true;
    bf16_t* O; int ldc; int ncols; const float* rs;
    __device__ __forceinline__ void operator()(const f32x4 (&acc)[2][2][4][2], const Unit& u, int wr, int wc, int fr, int fq) const {
        const int row0 = u.pm * BM + wr * 64 + fr, col0 = u.pn * BM + wc * 32 + 8 * fq;
        unsigned base[2];
#pragma unroll
        for (int bj = 0; bj < 2; ++bj) { const int c = col0 + bj * HALF;
            if (ldc) { base[bj] = (unsigned)c; }
            else if (c < 1152) { const int w3 = c / 384, rm = c % 384, h = rm >> 6, e = rm & 63; base[bj] = (unsigned)(ZA_OFF + (size_t)h * TH * 192 + w3 * 64 + e) | 1u; }
            else if (c < 2688) { const int cc = c - 1152, w4 = cc / 384, rm = cc % 384, h = rm / 96, e = rm % 96; base[bj] = (unsigned)(ZR_OFF + (size_t)h * TH * 384 + w4 * 96 + e) | 2u; }
            else { base[bj] = (unsigned)(ZC_OFF + (size_t)(c - 2688)) | 3u; } }
#pragma unroll
        for (int ai = 0; ai < 2; ++ai)
#pragma unroll
            for (int m = 0; m < 4; ++m) {
                const unsigned row = (unsigned)(row0 + ai * HALF + m * 16);
#pragma unroll
                for (int bj = 0; bj < 2; ++bj) {
                    const f32x4 v0 = acc[ai][bj][m][0], v1 = acc[ai][bj][m][1];
                    u32x4 w; w.x = cvt_pk_bf16(v0[0], v0[1]); w.y = cvt_pk_bf16(v0[2], v0[3]); w.z = cvt_pk_bf16(v1[0], v1[1]); w.w = cvt_pk_bf16(v1[2], v1[3]);
                    const unsigned code = base[bj] & 3u, pitch = code ? (96u << code) : (unsigned)ldc;
                    if (col0 + bj * HALF < ncols) *(u32x4*)(O + (size_t)((base[bj] & ~3u) + row * pitch)) = w;
                }
            }
    }
};

template <class Epi, bool ALIGN_EPI, bool SP2 = true>
__device__ __forceinline__ void gemm_phase(LAS unsigned char* lds, const Gemm g, const StaticOrder& S, const Epi& E, const int tid) {
    const int wid = __builtin_amdgcn_readfirstlane(tid >> 6), lane = tid & 63, wr = wid >> 2, wc = wid & 3, fr = lane & 15, fq = lane >> 4;
    const int K = g.K, nt = K / BK;
    unsigned voffA[2], voffB[2];
#pragma unroll
    for (int i = 0; i < 2; ++i) { int R, C; stage_rc(tid * 16 + i * 8192, R, C); const int Rb = Epi::PERM ? ((R & ~31) + perm32(R & 31)) : R;
        voffA[i] = (unsigned)(R * g.lda + C) * 2u; voffB[i] = (unsigned)(Rb * K + C) * 2u; }
    const size_t kstep = (size_t)(BK * 2);
    const size_t hstep = (size_t)HALF * K * 2;
    const size_t tstep = 2 * hstep;
    const size_t hstepA = (size_t)HALF * g.lda * 2, tstepA = 2 * hstepA;
    const unsigned ldsw = (unsigned)wid * 1024u;
    const int aoff = lds_byte(wr * 64 + fr, fq * 8), boff = lds_byte(wc * 32 + fr, fq * 8);
#define PG8_SA(b, h) (((b) * 2 + (h)) * HTB)
#define PG8_SB(b, h) ((4 + (b) * 2 + (h)) * HTB)
#define PG8_STAGE(bufoff, gbase, voff) do { _Pragma("unroll") for (int _i = 0; _i < 2; ++_i) \
        __builtin_amdgcn_global_load_lds((const unsigned*)((const char*)(gbase) + (voff)[_i]), (LAS unsigned*)(lds + (bufoff) + ldsw + _i * 8192), 16, 0, 0); } while (0)
#define PG8_LDA(dst, b, h) do { _Pragma("unroll") for (int m = 0; m < 4; ++m) _Pragma("unroll") for (int k = 0; k < 2; ++k) dst[m][k] = *(const LAS bf16x8*)(lds + PG8_SA(b, h) + aoff + m * 2048 + k * 1024); } while (0)
#define PG8_LDB(dst, b, h) do { _Pragma("unroll") for (int n = 0; n < 2; ++n) _Pragma("unroll") for (int k = 0; k < 2; ++k) dst[n][k] = *(const LAS bf16x8*)(lds + PG8_SB(b, h) + boff + n * 2048 + k * 1024); } while (0)
#define PG8_MMA(ai, bj, At, Bt) do { __builtin_amdgcn_s_setprio(1); _Pragma("unroll") for (int m = 0; m < 4; ++m) _Pragma("unroll") for (int n = 0; n < 2; ++n) _Pragma("unroll") for (int k = 0; k < 2; ++k) \
        acc[ai][bj][m][n] = __builtin_amdgcn_mfma_f32_16x16x32_bf16(Bt[n][k], At[m][k], acc[ai][bj][m][n], 0, 0, 0); __builtin_amdgcn_s_setprio(0); } while (0)
#define PG8_WAIT_V(n) asm volatile("s_waitcnt vmcnt(" #n ")" ::: "memory")
#define PG8_WAIT_L(n) asm volatile("s_waitcnt lgkmcnt(" #n ")" ::: "memory")
#define PG8_BAR __builtin_amdgcn_s_barrier()
#define PG8_SCHED __builtin_amdgcn_sched_barrier(0)
    Unit cur, nxt; int ui = 0;
    if (!S.next(0, cur)) return;
    f32x4 acc[2][2][4][2];
#pragma unroll
    for (int a = 0; a < 2; ++a)
#pragma unroll
        for (int b = 0; b < 2; ++b)
#pragma unroll
            for (int m = 0; m < 4; ++m)
#pragma unroll
                for (int n = 0; n < 2; ++n) acc[a][b][m][n] = (f32x4){0.f, 0.f, 0.f, 0.f};
    bf16x8 At[4][2], B0[2][2], B1[2][2];
    const char* cA = (const char*)g.A + (size_t)cur.pm * tstepA; const char* cB = (const char*)g.Bt + (size_t)cur.pn * tstep;
    if constexpr (SP2) {
    PG8_STAGE(PG8_SB(0, 0), cB, voffB); PG8_STAGE(PG8_SB(0, 1), cB + hstep, voffB); PG8_STAGE(PG8_SA(0, 0), cA, voffA); PG8_STAGE(PG8_SA(0, 1), cA + hstepA, voffA);
    if (wr == 1) PG8_BAR;
    PG8_WAIT_V(2); PG8_BAR;
    PG8_STAGE(PG8_SB(1, 0), cB + kstep, voffB); PG8_STAGE(PG8_SA(1, 0), cA + kstep, voffA); PG8_STAGE(PG8_SB(1, 1), cB + hstep + kstep, voffB);
    PG8_WAIT_V(6); PG8_BAR;
    } else {
    PG8_STAGE(PG8_SB(0, 0), cB, voffB); PG8_STAGE(PG8_SA(0, 0), cA, voffA); PG8_STAGE(PG8_SB(0, 1), cB + hstep, voffB); PG8_STAGE(PG8_SA(0, 1), cA + hstepA, voffA);
    if (wr == 1) PG8_BAR;
    PG8_WAIT_V(4); PG8_BAR;
    PG8_STAGE(PG8_SB(1, 0), cB + kstep, voffB); PG8_STAGE(PG8_SA(1, 0), cA + kstep, voffA); PG8_STAGE(PG8_SB(1, 1), cB + hstep + kstep, voffB);
    PG8_WAIT_V(6); PG8_BAR;
    }
    for (;;) {
        const bool has_next = S.next(ui + 1, nxt);
        const char* nA = has_next ? (const char*)g.A + (size_t)nxt.pm * tstepA : cA; const char* nB = has_next ? (const char*)g.Bt + (size_t)nxt.pn * tstep : cB;
        for (int t = 0; t < nt; t += 2) {
            const bool last = (t == nt - 2);
            const char* a1 = cA + (size_t)(t + 1) * kstep;
            const char* a2 = last ? nA : cA + (size_t)(t + 2) * kstep; const char* b2 = last ? nB : cB + (size_t)(t + 2) * kstep;
            const char* a3 = a2 + kstep; const char* b3 = b2 + kstep;
            if constexpr (!SP2) {
            PG8_LDB(B0, 0, 0); PG8_SCHED; PG8_LDA(At, 0, 0); PG8_STAGE(PG8_SA(1, 1), a1 + hstepA, voffA);
            PG8_WAIT_L(8); PG8_BAR; PG8_WAIT_L(0); PG8_MMA(0, 0, At, B0); PG8_BAR; PG8_SCHED;
            PG8_LDB(B1, 0, 1); PG8_STAGE(PG8_SB(0, 0), b2, voffB);
            PG8_BAR; PG8_WAIT_L(0); PG8_MMA(0, 1, At, B1); PG8_BAR;
            PG8_LDA(At, 0, 1); PG8_STAGE(PG8_SA(0, 0), a2, voffA);
            PG8_BAR; PG8_WAIT_L(0); PG8_MMA(1, 0, At, B0); PG8_BAR; PG8_SCHED;
            PG8_STAGE(PG8_SB(0, 1), b2 + hstep, voffB);
            PG8_WAIT_V(6); PG8_BAR; PG8_MMA(1, 1, At, B1); PG8_BAR;
            PG8_LDB(B0, 1, 0); PG8_SCHED; PG8_LDA(At, 1, 0); PG8_STAGE(PG8_SA(0, 1), a2 + hstepA, voffA);
            PG8_WAIT_L(8); PG8_BAR; PG8_WAIT_L(0); PG8_MMA(0, 0, At, B0); PG8_BAR; PG8_SCHED;
            PG8_LDB(B1, 1, 1); PG8_STAGE(PG8_SB(1, 0), b3, voffB);
            PG8_BAR; PG8_WAIT_L(0); PG8_MMA(0, 1, At, B1); PG8_BAR;
            PG8_LDA(At, 1, 1); PG8_STAGE(PG8_SA(1, 0), a3, voffA);
            PG8_BAR; PG8_WAIT_L(0); PG8_MMA(1, 0, At, B0); PG8_BAR; PG8_SCHED;
            PG8_STAGE(PG8_SB(1, 1), b3 + hstep, voffB);
            PG8_WAIT_V(6); PG8_BAR; PG8_MMA(1, 1, At, B1); PG8_BAR;
            } else {
            PG8_LDB(B0, 0, 0); PG8_LDB(B1, 0, 1); PG8_SCHED; PG8_LDA(At, 0, 0); PG8_STAGE(PG8_SA(1, 1), a1 + hstepA, voffA);
            PG8_WAIT_V(8); PG8_WAIT_L(0); PG8_BAR; PG8_MMA(0, 0, At, B0); PG8_MMA(0, 1, At, B1); PG8_BAR; PG8_SCHED;
            PG8_LDA(At, 0, 1); PG8_STAGE(PG8_SB(0, 0), b2, voffB); PG8_STAGE(PG8_SB(0, 1), b2 + hstep, voffB); PG8_STAGE(PG8_SA(0, 0), a2, voffA);
            PG8_WAIT_V(8); PG8_WAIT_L(0); PG8_BAR; PG8_MMA(1, 0, At, B0); PG8_MMA(1, 1, At, B1); PG8_BAR; PG8_SCHED;
            PG8_LDB(B0, 1, 0); PG8_LDB(B1, 1, 1); PG8_SCHED; PG8_LDA(At, 1, 0); PG8_STAGE(PG8_SA(0, 1), a2 + hstepA, voffA);
            PG8_WAIT_V(8); PG8_WAIT_L(0); PG8_BAR; PG8_MMA(0, 0, At, B0); PG8_MMA(0, 1, At, B1); PG8_BAR; PG8_SCHED;
            PG8_LDA(At, 1, 1); PG8_STAGE(PG8_SB(1, 0), b3, voffB); PG8_STAGE(PG8_SB(1, 1), b3 + hstep, voffB); PG8_STAGE(PG8_SA(1, 0), a3, voffA);
            PG8_WAIT_V(8); PG8_WAIT_L(0); PG8_BAR; PG8_MMA(1, 0, At, B0); PG8_MMA(1, 1, At, B1); PG8_BAR; PG8_SCHED;
            }
        }
        if constexpr (ALIGN_EPI) { if (wr == 0) PG8_BAR; }
        E(acc, cur, wr, wc, fr, fq);
        if (!has_next) break;
#pragma unroll
        for (int a = 0; a < 2; ++a)
#pragma unroll
            for (int b = 0; b < 2; ++b)
#pragma unroll
                for (int m = 0; m < 4; ++m)
#pragma unroll
                    for (int n = 0; n < 2; ++n) acc[a][b][m][n] = (f32x4){0.f, 0.f, 0.f, 0.f};
        cur = nxt; cA = nA; cB = nB; ++ui;
        if constexpr (ALIGN_EPI) { if (wr == 1) PG8_BAR; }
    }
    PG8_WAIT_V(0);
    if constexpr (!ALIGN_EPI) { if (wr == 0) PG8_BAR; }
    PG8_BAR;
#undef PG8_SA
#undef PG8_SB
#undef PG8_STAGE
#undef PG8_LDA
#undef PG8_LDB
#undef PG8_MMA
#undef PG8_WAIT_V
#undef PG8_WAIT_L
#undef PG8_BAR
#undef PG8_SCHED
}
}

struct Params { const float* in[13]; float* out; unsigned char* ws; };

__device__ __forceinline__ void transpose_item(const float* W, int K, int N, bf16_t* WT, int mode, LAS float* scr, int item, int lane, const float* gk) {
    const int nblk = N / 32, kb = item / nblk, nb = item % nblk, k0 = 64 * kb, n0 = 32 * nb;
    const int r0 = (mode == 0) ? n0 : ((n0 >> 7) * 256 + (n0 & 127) + (mode == 2 ? 128 : 0));
    f32x4 wv[8];
#pragma unroll
    for (int i = 0; i < 8; ++i) { const int kk = 8 * i + (lane >> 3); wv[i] = *(const f32x4*)(W + (size_t)(k0 + kk) * N + n0 + 4 * (lane & 7)); }
#pragma unroll
    for (int i = 0; i < 8; ++i) { const int kk = 8 * i + (lane >> 3); const float gg = gk ? gk[k0 + kk] : 1.0f; LAS float* d = scr + kk * 33 + 4 * (lane & 7);
        d[0] = wv[i].x * gg; d[1] = wv[i].y * gg; d[2] = wv[i].z * gg; d[3] = wv[i].w * gg; }
    asm volatile("s_waitcnt lgkmcnt(0)" ::: "memory");
    const int c = lane & 7;
#pragma unroll
    for (int j = 0; j < 4; ++j) { const int n = (lane >> 3) + 8 * j; const LAS float* s = scr + (8 * c) * 33 + n;
        u32x4 o; o.x = cvt_pk_bf16(s[0 * 33], s[1 * 33]); o.y = cvt_pk_bf16(s[2 * 33], s[3 * 33]); o.z = cvt_pk_bf16(s[4 * 33], s[5 * 33]); o.w = cvt_pk_bf16(s[6 * 33], s[7 * 33]);
        *(u32x4*)(WT + (size_t)(r0 + n) * K + k0 + 8 * c) = o; }
    asm volatile("s_waitcnt lgkmcnt(0)" ::: "memory");
}

__device__ __forceinline__ void phase_weights(const Params& P, LAS unsigned char* lds, int gw, int ngw, int wave, int lane, int gtid, int nthr) {
    LAS float* scr = (LAS float*)(lds + wave * 8448);
    bf16_t* WB = (bf16_t*)(P.ws + WS_W);
    constexpr int I_G = 16 * 88, I_D = 44 * 32, I_I = 16 * 108, I_O = 16 * 32;
    constexpr int PER_LAYER = 6 * I_G + I_I + I_O;
    static_assert(I_G == I_D, "");
    for (int it = gw; it < DEPTH * PER_LAYER; it += ngw) {
        const int l = it / PER_LAYER; int r = it % PER_LAYER;
        bf16_t* wl = WB + (size_t)l * L_ELEMS; const float* gl = P.in[2] + (size_t)l * 6 * D;
        if (r < I_G) { transpose_item(P.in[3] + (size_t)l * D * FF, D, FF, wl + L_UP1, 1, scr, r, lane, gl); continue; } r -= I_G;
        if (r < I_G) { transpose_item(P.in[4] + (size_t)l * D * FF, D, FF, wl + L_UP1, 2, scr, r, lane, gl); continue; } r -= I_G;
        if (r < I_D) { transpose_item(P.in[5] + (size_t)l * D * FF, FF, D, wl + L_DN1, 0, scr, r, lane, nullptr); continue; } r -= I_D;
        if (r < I_I) { transpose_item(P.in[6] + (size_t)l * D * NIN, D, NIN, wl + L_IN, 0, scr, r, lane, gl + 2 * D); continue; } r -= I_I;
        if (r < I_O) { transpose_item(P.in[9] + (size_t)l * D * D, D, D, wl + L_OUT, 0, scr, r, lane, nullptr); continue; } r -= I_O;
        if (r < I_G) { transpose_item(P.in[10] + (size_t)l * D * FF, D, FF, wl + L_UP2, 1, scr, r, lane, gl + 4 * D); continue; } r -= I_G;
        if (r < I_G) { transpose_item(P.in[11] + (size_t)l * D * FF, D, FF, wl + L_UP2, 2, scr, r, lane, gl + 4 * D); continue; } r -= I_G;
        transpose_item(P.in[12] + (size_t)l * D * FF, FF, D, wl + L_DN2, 0, scr, r, lane, nullptr);
    }
    for (int v = gtid; v < DEPTH * 16384; v += nthr) { const int l = v / 16384, o = v % 16384;
        *(u32x4*)(WB + (size_t)l * L_ELEMS + L_IN + (size_t)NIN * D + (size_t)o * 8) = (u32x4){0u, 0u, 0u, 0u}; }
}

constexpr int RP = 4, XP = 2048;
__device__ __forceinline__ void row_pass(const bf16_t* OB, const float* x32, bf16_t* X16, float* RS, float* out32, const float* gpost, float cres, int rows, int gw, int ngw, int lane) {
    f32x4 gpo[4];
#pragma unroll
    for (int j = 0; j < 4; ++j) gpo[j] = OB ? ((const f32x4*)gpost)[lane + 64 * j] : (f32x4){0.f, 0.f, 0.f, 0.f};
    for (int row0 = gw; row0 < rows; row0 += RP * ngw) {
        f32x4 xv[RP][4]; u32x2 ow[RP][4];
#pragma unroll
        for (int k = 0; k < RP; ++k) { const size_t row = (size_t)row0 + (size_t)k * ngw;
            if (x32) { const f32x4* xr = (const f32x4*)(x32 + row * D) + lane;
#pragma unroll
                for (int j = 0; j < 4; ++j) xv[k][j] = __builtin_nontemporal_load(xr + 64 * j); }
            else { const u32x2* xr = (const u32x2*)(X16 + row * XP) + lane;
#pragma unroll
                for (int j = 0; j < 4; ++j) { const u32x2 w = xr[64 * j]; xv[k][j] = (f32x4){bf_lo(w.x), bf_hi(w.x), bf_lo(w.y), bf_hi(w.y)}; }
                const float ri = RS[row];
#pragma unroll
                for (int j = 0; j < 4; ++j) xv[k][j] = xv[k][j] * ri; }
            if (OB) { const u32x2* orow = (const u32x2*)(OB + row * D) + lane;
#pragma unroll
                for (int j = 0; j < 4; ++j) ow[k][j] = __builtin_nontemporal_load(orow + 64 * j); } }
        if (OB) {
            float ss[RP];
#pragma unroll
            for (int k = 0; k < RP; ++k) { ss[k] = 0.f;
#pragma unroll
                for (int j = 0; j < 4; ++j) { const float a = bf_lo(ow[k][j].x), b = bf_hi(ow[k][j].x), c = bf_lo(ow[k][j].y), d = bf_hi(ow[k][j].y); ss[k] += (a * a + b * b) + (c * c + d * d); } }
#pragma unroll
            for (int k = 0; k < RP; ++k) ss[k] += shx<1>(ss[k], lane);
#pragma unroll
            for (int k = 0; k < RP; ++k) ss[k] += shx<2>(ss[k], lane);
#pragma unroll
            for (int k = 0; k < RP; ++k) ss[k] += shx<4>(ss[k], lane);
#pragma unroll
            for (int k = 0; k < RP; ++k) ss[k] += shx<8>(ss[k], lane);
#pragma unroll
            for (int k = 0; k < RP; ++k) ss[k] += shx<16>(ss[k], lane);
#pragma unroll
            for (int k = 0; k < RP; ++k) ss[k] += shx<32>(ss[k], lane);
#pragma unroll
            for (int k = 0; k < RP; ++k) { const float rs = rsqrtf(ss[k] * (1.f / D) + EPS) * cres;
#pragma unroll
                for (int j = 0; j < 4; ++j) { const f32x4 ov = (f32x4){bf_lo(ow[k][j].x), bf_hi(ow[k][j].x), bf_lo(ow[k][j].y), bf_hi(ow[k][j].y)};
                    xv[k][j] = xv[k][j] + ov * gpo[j] * rs; } }
        }
        if (out32) {
#pragma unroll
            for (int k = 0; k < RP; ++k) { const size_t row = (size_t)row0 + (size_t)k * ngw; f32x4* xo = (f32x4*)(out32 + row * D) + lane;
#pragma unroll
                for (int j = 0; j < 4; ++j) xo[64 * j] = xv[k][j]; }
        } else {
            float ss[RP];
#pragma unroll
            for (int k = 0; k < RP; ++k) { ss[k] = 0.f;
#pragma unroll
                for (int j = 0; j < 4; ++j) ss[k] += (xv[k][j].x * xv[k][j].x + xv[k][j].y * xv[k][j].y) + (xv[k][j].z * xv[k][j].z + xv[k][j].w * xv[k][j].w); }
#pragma unroll
            for (int k = 0; k < RP; ++k) ss[k] += shx<1>(ss[k], lane);
#pragma unroll
            for (int k = 0; k < RP; ++k) ss[k] += shx<2>(ss[k], lane);
#pragma unroll
            for (int k = 0; k < RP; ++k) ss[k] += shx<4>(ss[k], lane);
#pragma unroll
            for (int k = 0; k < RP; ++k) ss[k] += shx<8>(ss[k], lane);
#pragma unroll
            for (int k = 0; k < RP; ++k) ss[k] += shx<16>(ss[k], lane);
#pragma unroll
            for (int k = 0; k < RP; ++k) ss[k] += shx<32>(ss[k], lane);
#pragma unroll
            for (int k = 0; k < RP; ++k) { const size_t row = (size_t)row0 + (size_t)k * ngw;
                const float ms = ss[k] * (1.f / D) + EPS, rs = rsqrtf(ms);
                if (lane == 0) RS[row] = ms * rs;
                u32x2* ao = (u32x2*)(X16 + row * XP) + lane;
#pragma unroll
                for (int j = 0; j < 4; ++j) { const f32x4 v = xv[k][j] * rs; u32x2 w; w.x = cvt_pk_bf16(v.x, v.y); w.y = cvt_pk_bf16(v.z, v.w); ao[64 * j] = w; } }
        }
    }
}

constexpr int AK_PITCH = 144, AV_PITCH = 528, AK_BYTES = 256 * AK_PITCH;
struct AttnStage { u32x4 k[4], v[4]; bf16x8 q[2]; };
__device__ __forceinline__ AttnStage attn_load(const bf16_t* Z, int S, int it, int tid, int wave, int lane) {
    AttnStage st;
    const int p = it / 1536, rem = it % 1536, h = rem / 256, gb = rem % 256;
    const int bps = S >> 7, b = gb / bps, rb = gb % bps;
    const int dl = 2 * p, d = 1 << dl, L = S >> dl, nb = bps >> dl;
    const int r = rb / nb, lb = rb % nb, l0 = lb * 128;
    const int tok0 = b * S + r;
#pragma unroll
    for (int q = 0; q < 4; ++q) {
        const int idx = tid + 512 * q, i = idx >> 3, g = idx & 7, lk = l0 - 64 + i;
        st.k[q] = (u32x4){0u, 0u, 0u, 0u}; st.v[q] = (u32x4){0u, 0u, 0u, 0u};
        if (lk >= 0 && lk < L) { const bf16_t* zr = Z + ZA_OFF + ((size_t)h * TH + (size_t)(tok0 + lk * d)) * 192 + g * 8;
            st.k[q] = *(const u32x4*)(zr + 64); st.v[q] = *(const u32x4*)(zr + 128); }
    }
    const int fr = lane & 15, fq = lane >> 4;
    const size_t tq = (size_t)(tok0 + (l0 + 16 * wave + fr) * d);
#pragma unroll
    for (int kc = 0; kc < 2; ++kc) st.q[kc] = *(const bf16x8*)(Z + ZA_OFF + ((size_t)h * TH + tq) * 192 + kc * 32 + fq * 8);
    return st;
}
__device__ __forceinline__ AttnStage attn_item(LAS unsigned char* lds, const bf16_t* Z, bf16_t* PO, float* LSE, int S, int it, int itn, const AttnStage st, int tid, int wave, int lane) {
    const int p = it / 1536, rem = it % 1536, h = rem / 256, gb = rem % 256;
    const int bps = S >> 7, b = gb / bps, rb = gb % bps;
    const int dl = 2 * p, d = 1 << dl, L = S >> dl, nb = bps >> dl;
    const int r = rb / nb, lb = rb % nb, l0 = lb * 128;
    const int tok0 = b * S + r;
    LAS unsigned char* sK = lds; LAS unsigned char* sV = lds + AK_BYTES;
#pragma unroll
    for (int q = 0; q < 4; ++q) {
        const int idx = tid + 512 * q, i = idx >> 3, g = idx & 7;
        const u32x4 kv = st.k[q], vv = st.v[q];
        *(LAS u32x4*)(sK + i * AK_PITCH + g * 16) = kv;
        LAS bf16_t* vt = (LAS bf16_t*)(sV + (g * 8) * AV_PITCH + i * 2);
        vt[0 * (AV_PITCH / 2)] = (bf16_t)(vv.x & 0xffffu); vt[1 * (AV_PITCH / 2)] = (bf16_t)(vv.x >> 16);
        vt[2 * (AV_PITCH / 2)] = (bf16_t)(vv.y & 0xffffu); vt[3 * (AV_PITCH / 2)] = (bf16_t)(vv.y >> 16);
        vt[4 * (AV_PITCH / 2)] = (bf16_t)(vv.z & 0xffffu); vt[5 * (AV_PITCH / 2)] = (bf16_t)(vv.z >> 16);
        vt[6 * (AV_PITCH / 2)] = (bf16_t)(vv.w & 0xffffu); vt[7 * (AV_PITCH / 2)] = (bf16_t)(vv.w >> 16);
    }
    bf16x8 qf[2]; qf[0] = st.q[0]; qf[1] = st.q[1];
    __syncthreads();
    const AttnStage nst = attn_load(Z, S, itn, tid, wave, lane);
    const int fr = lane & 15, fq = lane >> 4;
    const int lq = l0 + 16 * wave + fr;
    const size_t tq = (size_t)(tok0 + lq * d);
    f32x4 s[9];
    __builtin_amdgcn_s_setprio(1);
#pragma unroll
    for (int kt = 0; kt < 9; ++kt) { s[kt] = (f32x4){0.f, 0.f, 0.f, 0.f};
#pragma unroll
        for (int kc = 0; kc < 2; ++kc) { const bf16x8 a = *(const LAS bf16x8*)(sK + (16 * wave + kt * 16 + fr) * AK_PITCH + (kc * 32 + fq * 8) * 2);
            s[kt] = __builtin_amdgcn_mfma_f32_16x16x32_bf16(a, qf[kc], s[kt], 0, 0, 0); } }
    __builtin_amdgcn_s_setprio(0);
    const float slope = (h == 0) ? 0.25f : (h == 1) ? 0.0625f : (h == 2) ? 0.015625f : (h == 3) ? 0.00390625f : (h == 4) ? 0.5f : 0.125f;
    const float c1 = 0.125f * LOG2E, c2 = slope * (float)d * LOG2E;
    float mx = -1e30f;
#pragma unroll
    for (int kt = 0; kt < 9; ++kt)
#pragma unroll
        for (int j = 0; j < 4; ++j) { const int ki = kt * 16 + fq * 4 + j; const int rel = ki - 64 - fr; const int ar = rel < 0 ? -rel : rel; const int lk = l0 - 64 + 16 * wave + ki;
            const bool valid = (ar <= 64) && (lk >= 0) && (lk < L);
            const float v = valid ? (s[kt][j] * c1 - c2 * (float)ar) : -1e30f; s[kt][j] = v; mx = fmaxf(mx, v); }
    mx = fmaxf(mx, shx<16>(mx, lane)); mx = fmaxf(mx, shx<32>(mx, lane));
    float sum = 0.f; bf16x4 pf[9];
#pragma unroll
    for (int kt = 0; kt < 9; ++kt) { float e[4];
#pragma unroll
        for (int j = 0; j < 4; ++j) { e[j] = fexp2(s[kt][j] - mx); sum += e[j]; }
        const unsigned w0 = cvt_pk_bf16(e[0], e[1]), w1 = cvt_pk_bf16(e[2], e[3]);
        pf[kt] = (bf16x4){(short)(w0 & 0xffffu), (short)(w0 >> 16), (short)(w1 & 0xffffu), (short)(w1 >> 16)}; }
    sum += shx<16>(sum, lane); sum += shx<32>(sum, lane);
    f32x4 o[4];
#pragma unroll
    for (int dt = 0; dt < 4; ++dt) o[dt] = (f32x4){0.f, 0.f, 0.f, 0.f};
    __builtin_amdgcn_s_setprio(1);
#pragma unroll
    for (int kt = 0; kt < 9; ++kt)
#pragma unroll
        for (int dt = 0; dt < 4; ++dt) { const bf16x4 a = *(const LAS bf16x4*)(sV + (dt * 16 + fr) * AV_PITCH + (16 * wave + kt * 16 + fq * 4) * 2);
            o[dt] = __builtin_amdgcn_mfma_f32_16x16x16bf16_1k(a, pf[kt], o[dt], 0, 0, 0); }
    __builtin_amdgcn_s_setprio(0);
    const float inv = 1.0f / sum;
    bf16_t* po = PO + tq * 384 + h * 64 + fq * 4;
#pragma unroll
    for (int dt = 0; dt < 4; ++dt) { u32x2 w; w.x = cvt_pk_bf16(o[dt][0] * inv, o[dt][1] * inv); w.y = cvt_pk_bf16(o[dt][2] * inv, o[dt][3] * inv); *(u32x2*)(po + dt * 16) = w; }
    if (fq == 0) LSE[tq * 6 + h] = mx + __log2f(sum);
    __syncthreads();
    return nst;
}

constexpr int RT_PITCH = 272;
constexpr int RK_PITCH = 208;
__device__ __forceinline__ void retkv_item(LAS unsigned char* lds, const bf16_t* Z, bf16_t* ST, int it, float lgf2, float lgb2, int tid, int wave, int lane) {
    const int gc = it >> 2, h = it & 3;
    const size_t t0 = (size_t)gc * 128;
    LAS unsigned char* sKf = lds; LAS unsigned char* sKb = lds + 96 * RT_PITCH; LAS unsigned char* sV = lds + 2 * 96 * RT_PITCH;
    const float ksc = 0.10206207261596577f;
#pragma unroll
    for (int q = 0; q < 3; ++q) {
        const int idx = tid + 512 * q, m = idx / 12, g = idx % 12;
        const bf16_t* zr = Z + ZR_OFF + ((size_t)h * TH + t0 + m) * 384 + g * 8;
        const u32x4 kv = *(const u32x4*)(zr + 96), vv = *(const u32x4*)(zr + 192);
        const float wf = fexp2(lgf2 * (float)(127 - m)) * ksc, wb = fexp2(lgb2 * (float)m) * ksc;
        const unsigned kw[4] = {kv.x, kv.y, kv.z, kv.w}, vw[4] = {vv.x, vv.y, vv.z, vv.w};
#pragma unroll
        for (int e2 = 0; e2 < 4; ++e2) {
            const float k0 = bf_lo(kw[e2]), k1 = bf_hi(kw[e2]);
            const unsigned pfw = cvt_pk_bf16(k0 * wf, k1 * wf), pbw = cvt_pk_bf16(k0 * wb, k1 * wb);
            const int ro = (g * 8 + 2 * e2) * RT_PITCH + m * 2;
            *(LAS bf16_t*)(sKf + ro) = (bf16_t)(pfw & 0xffffu); *(LAS bf16_t*)(sKf + ro + RT_PITCH) = (bf16_t)(pfw >> 16);
            *(LAS bf16_t*)(sKb + ro) = (bf16_t)(pbw & 0xffffu); *(LAS bf16_t*)(sKb + ro + RT_PITCH) = (bf16_t)(pbw >> 16);
            *(LAS bf16_t*)(sV + ro) = (bf16_t)(vw[e2] & 0xffffu); *(LAS bf16_t*)(sV + ro + RT_PITCH) = (bf16_t)(vw[e2] >> 16);
        }
    }
    __syncthreads();
    const int fr = lane & 15, fq = lane >> 4;
    bf16_t* stb = ST + (size_t)it * 2 * 9216;
    for (int tt = wave * 9; tt < wave * 9 + 9; ++tt) {
        const int dir = tt / 36, rm = tt % 36, dt = rm / 6, et = rm % 6;
        LAS unsigned char* sK = dir ? sKb : sKf;
        f32x4 acc = (f32x4){0.f, 0.f, 0.f, 0.f};
#pragma unroll
        for (int ks = 0; ks < 4; ++ks) {
            const bf16x8 a = *(const LAS bf16x8*)(sK + (dt * 16 + fr) * RT_PITCH + (ks * 32 + fq * 8) * 2);
            const bf16x8 bb = *(const LAS bf16x8*)(sV + (et * 16 + fr) * RT_PITCH + (ks * 32 + fq * 8) * 2);
            acc = __builtin_amdgcn_mfma_f32_16x16x32_bf16(a, bb, acc, 0, 0, 0);
        }
        asm volatile("s_nop 7\n\ts_nop 7\n\ts_nop 7" : "+v"(acc));
        u32x2 w; w.x = cvt_pk_bf16(acc[0], acc[1]); w.y = cvt_pk_bf16(acc[2], acc[3]);
        __hip_atomic_store((unsigned long long*)(stb + (size_t)dir * 9216 + (et * 16 + fr) * 96 + dt * 16 + fq * 4), (unsigned long long)w.x | ((unsigned long long)w.y << 32), __ATOMIC_RELAXED, __HIP_MEMORY_SCOPE_AGENT);
    }
    __syncthreads();
}

__device__ __forceinline__ void ret_scan(bf16_t* ST, int S, volatile LAS float* lg2, int gtid, int nthr) {
    const int nc = S >> 7, nseq = TH / S, nvec = nseq * 4 * 2 * 1152;
    for (int v = gtid; v < nvec; v += nthr) {
        const int dv = v % 1152, t2 = v / 1152, dir = t2 & 1, h = (t2 >> 1) & 3, b = t2 >> 3;
        const float gC = fexp2(lg2[dir * 4 + h] * 128.f);
        float s[8];
#pragma unroll
        for (int k = 0; k < 8; ++k) s[k] = 0.f;
        for (int i0 = 0; i0 < nc; i0 += 16) {
            u32x4 t[16];
#pragma unroll
            for (int k = 0; k < 16; ++k) { const int i = i0 + k, c = dir ? nc - 1 - i : i;
                t[k] = *(const u32x4*)(ST + ((((size_t)(b * nc + c) * 4 + h) * 2 + dir) * 9216 + dv * 8)); }
#pragma unroll
            for (int k = 0; k < 16; ++k) { const int i = i0 + k, c = dir ? nc - 1 - i : i;
                u32x4 o; o.x = cvt_pk_bf16(s[0], s[1]); o.y = cvt_pk_bf16(s[2], s[3]); o.z = cvt_pk_bf16(s[4], s[5]); o.w = cvt_pk_bf16(s[6], s[7]);
                *(u32x4*)(ST + ((((size_t)(b * nc + c) * 4 + h) * 2 + dir) * 9216 + dv * 8)) = o;
                s[0] = gC * s[0] + bf_lo(t[k].x); s[1] = gC * s[1] + bf_hi(t[k].x); s[2] = gC * s[2] + bf_lo(t[k].y); s[3] = gC * s[3] + bf_hi(t[k].y);
                s[4] = gC * s[4] + bf_lo(t[k].z); s[5] = gC * s[5] + bf_hi(t[k].z); s[6] = gC * s[6] + bf_lo(t[k].w); s[7] = gC * s[7] + bf_hi(t[k].w); }
        }
    }
}

__device__ __forceinline__ void retout_item(LAS unsigned char* lds, const bf16_t* Z, const bf16_t* ST, bf16_t* YA, int it, float lgf2, float lgb2, int tid, int wave, int lane) {
    const int gc = it >> 2, h = it & 3;
    const size_t t0 = (size_t)gc * 128;
    LAS unsigned char* sK = lds; LAS unsigned char* sV = lds + 128 * RK_PITCH; LAS unsigned char* sS = sV + 96 * RT_PITCH;
    const bf16_t* stb = ST + (size_t)it * 2 * 9216;
#pragma unroll
    for (int q = 0; q < 5; ++q) { const int c = tid + 512 * q;
        if (c < 2304) { const int dir = c / 1152, rm = c % 1152, e = rm / 12, part = rm % 12;
            *(LAS u32x4*)(sS + (dir * 96 + e) * RK_PITCH + part * 16) = *(const u32x4*)(stb + (size_t)c * 8); } }
#pragma unroll
    for (int q = 0; q < 3; ++q) {
        const int idx = tid + 512 * q, m = idx / 12, g = idx % 12;
        const bf16_t* zr = Z + ZR_OFF + ((size_t)h * TH + t0 + m) * 384 + g * 8;
        const u32x4 kv = *(const u32x4*)(zr + 96), vv = *(const u32x4*)(zr + 192);
        *(LAS u32x4*)(sK + m * RK_PITCH + g * 16) = kv;
        const unsigned vw[4] = {vv.x, vv.y, vv.z, vv.w};
#pragma unroll
        for (int e2 = 0; e2 < 4; ++e2) { const int ro = (g * 8 + 2 * e2) * RT_PITCH + m * 2;
            *(LAS bf16_t*)(sV + ro) = (bf16_t)(vw[e2] & 0xffffu); *(LAS bf16_t*)(sV + ro + RT_PITCH) = (bf16_t)(vw[e2] >> 16); }
    }
    __syncthreads();
    const int fr = lane & 15, fq = lane >> 4;
    const int n = 16 * wave + fr;
    const size_t tq = t0 + n;
    const float ksc = 0.10206207261596577f;
    bf16x8 qf[3];
#pragma unroll
    for (int ks = 0; ks < 3; ++ks) qf[ks] = *(const bf16x8*)(Z + ZR_OFF + ((size_t)h * TH + tq) * 384 + ks * 32 + fq * 8);
    f32x4 o[6];
#pragma unroll
    for (int et = 0; et < 6; ++et) o[et] = (f32x4){0.f, 0.f, 0.f, 0.f};
#pragma unroll
    for (int mt = 0; mt < 8; ++mt) {
        f32x4 s = (f32x4){0.f, 0.f, 0.f, 0.f};
#pragma unroll
        for (int ks = 0; ks < 3; ++ks) { const bf16x8 a = *(const LAS bf16x8*)(sK + (mt * 16 + fr) * RK_PITCH + (ks * 32 + fq * 8) * 2);
            s = __builtin_amdgcn_mfma_f32_16x16x32_bf16(a, qf[ks], s, 0, 0, 0); }
        float pv[4];
#pragma unroll
        for (int j = 0; j < 4; ++j) { const int mm = mt * 16 + fq * 4 + j; const int df = n - mm;
            const float dec = (df >= 0) ? fexp2(lgf2 * (float)df) : fexp2(lgb2 * (float)(-df));
            pv[j] = s[j] * ksc * dec; }
        const unsigned w0 = cvt_pk_bf16(pv[0], pv[1]), w1 = cvt_pk_bf16(pv[2], pv[3]);
        const bf16x4 pfr = (bf16x4){(short)(w0 & 0xffffu), (short)(w0 >> 16), (short)(w1 & 0xffffu), (short)(w1 >> 16)};
#pragma unroll
        for (int et = 0; et < 6; ++et) { const bf16x4 a = *(const LAS bf16x4*)(sV + (et * 16 + fr) * RT_PITCH + (mt * 16 + fq * 4) * 2);
            o[et] = __builtin_amdgcn_mfma_f32_16x16x16bf16_1k(a, pfr, o[et], 0, 0, 0); }
    }
    __builtin_amdgcn_s_setprio(1);
    const float qwf = fexp2(lgf2 * (float)(n + 1)), qwb = fexp2(lgb2 * (float)(128 - n));
#pragma unroll
    for (int dir = 0; dir < 2; ++dir) {
        const float qw = dir ? qwb : qwf;
#pragma unroll
        for (int et = 0; et < 6; ++et) {
            f32x4 x = (f32x4){0.f, 0.f, 0.f, 0.f};
#pragma unroll
            for (int ks = 0; ks < 3; ++ks) { const bf16x8 a = *(const LAS bf16x8*)(sS + (dir * 96 + et * 16 + fr) * RK_PITCH + (ks * 32 + fq * 8) * 2);
                x = __builtin_amdgcn_mfma_f32_16x16x32_bf16(a, qf[ks], x, 0, 0, 0); }
#ifndef DBG_NOCROSS
            o[et] = o[et] + x * qw;
#endif
        }
    }
#ifdef DBG_SANITIZE
#pragma unroll
    for (int et = 0; et < 6; ++et)
#pragma unroll
        for (int j = 0; j < 4; ++j) o[et][j] = (fabsf(o[et][j]) < 1e30f) ? o[et][j] : 0.f;
#endif
    __builtin_amdgcn_s_setprio(0);
    float sm = 0.f;
#pragma unroll
    for (int et = 0; et < 6; ++et) sm += (o[et][0] + o[et][1]) + (o[et][2] + o[et][3]);
    sm += shx<16>(sm, lane); sm += shx<32>(sm, lane);
    const float mu = sm * (1.f / 96.f);
    float sq = 0.f;
#pragma unroll
    for (int et = 0; et < 6; ++et)
#pragma unroll
        for (int j = 0; j < 4; ++j) { const float dd = o[et][j] - mu; o[et][j] = dd; sq += dd * dd; }
    sq += shx<16>(sq, lane); sq += shx<32>(sq, lane);
    const float rs = rsqrtf(sq * (1.f / 96.f) + EPS);
#pragma unroll
    for (int et = 0; et < 6; ++et) {
        const u32x2 gw = *(const u32x2*)(Z + ZR_OFF + ((size_t)h * TH + tq) * 384 + 288 + et * 16 + fq * 4);
        const float g4[4] = {bf_lo(gw.x), bf_hi(gw.x), bf_lo(gw.y), bf_hi(gw.y)};
        float y[4];
#pragma unroll
        for (int j = 0; j < 4; ++j) { const float gg = g4[j]; y[j] = o[et][j] * rs * (gg * __builtin_amdgcn_rcpf(1.0f + __expf(-gg))); }
        u32x2 w; w.x = cvt_pk_bf16(y[0], y[1]); w.y = cvt_pk_bf16(y[2], y[3]);
#ifdef DBG_ZRET
        w.x = 0u; w.y = 0u;
#endif
        *(u32x2*)(YA + tq * D + 384 + h * 96 + et * 16 + fq * 4) = w;
    }
    __syncthreads();
}

struct MergeLd { float l0, l1, l2; u32x4 a, b, c; };
__device__ __forceinline__ MergeLd merge_load(const bf16_t* PO01, const bf16_t* PO2, const float* LSE, int it) {
    const int tok = it / 48, grp = it % 48, h = grp >> 3; MergeLd m;
    m.l0 = LSE[(size_t)tok * 6 + h]; m.l1 = LSE[(size_t)TH * 6 + (size_t)tok * 6 + h]; m.l2 = LSE[(size_t)2 * TH * 6 + (size_t)tok * 6 + h];
    m.a = *(const u32x4*)(PO01 + (size_t)tok * 384 + grp * 8); m.b = *(const u32x4*)(PO01 + (size_t)TH * 384 + (size_t)tok * 384 + grp * 8); m.c = *(const u32x4*)(PO2 + (size_t)tok * 384 + grp * 8);
    return m;
}
__device__ __forceinline__ void merge_store(const MergeLd& m, bf16_t* YA, int it) {
    const int tok = it / 48, grp = it % 48;
    const float M = fmaxf(m.l0, fmaxf(m.l1, m.l2));
    float w0 = fexp2(m.l0 - M), w1 = fexp2(m.l1 - M), w2 = fexp2(m.l2 - M);
    const float inv = 1.0f / (w0 + w1 + w2); w0 *= inv; w1 *= inv; w2 *= inv;
    const u32x4 a = m.a, b = m.b, c = m.c; u32x4 o;
    o.x = cvt_pk_bf16(w0 * bf_lo(a.x) + w1 * bf_lo(b.x) + w2 * bf_lo(c.x), w0 * bf_hi(a.x) + w1 * bf_hi(b.x) + w2 * bf_hi(c.x));
    o.y = cvt_pk_bf16(w0 * bf_lo(a.y) + w1 * bf_lo(b.y) + w2 * bf_lo(c.y), w0 * bf_hi(a.y) + w1 * bf_hi(b.y) + w2 * bf_hi(c.y));
    o.z = cvt_pk_bf16(w0 * bf_lo(a.z) + w1 * bf_lo(b.z) + w2 * bf_lo(c.z), w0 * bf_hi(a.z) + w1 * bf_hi(b.z) + w2 * bf_hi(c.z));
    o.w = cvt_pk_bf16(w0 * bf_lo(a.w) + w1 * bf_lo(b.w) + w2 * bf_lo(c.w), w0 * bf_hi(a.w) + w1 * bf_hi(b.w) + w2 * bf_hi(c.w));
#ifdef DBG_ZATT
    o = (u32x4){0u, 0u, 0u, 0u};
#endif
    *(u32x4*)(YA + (size_t)tok * D + grp * 8) = o;
}
struct ConvLd { u32x4 bc, cc0, uc0, cc1, uc1, cc2, uc2; };
__device__ __forceinline__ ConvLd conv_load(const bf16_t* Z, int S, int it) {
    const int tok = it >> 5, ch0 = (it & 31) * 8, pos = tok % S; ConvLd v;
    const bf16_t* zr = Z + ZC_OFF + (size_t)tok * 768;
    v.bc = *(const u32x4*)(zr + ch0); v.cc1 = *(const u32x4*)(zr + 256 + ch0); v.uc1 = *(const u32x4*)(zr + 512 + ch0);
    v.cc0 = (u32x4){0u, 0u, 0u, 0u}; v.uc0 = v.cc0; v.cc2 = v.cc0; v.uc2 = v.cc0;
    if (pos > 0) { v.cc0 = *(const u32x4*)(zr - 768 + 256 + ch0); v.uc0 = *(const u32x4*)(zr - 768 + 512 + ch0); }
    if (pos < S - 1) { v.cc2 = *(const u32x4*)(zr + 768 + 256 + ch0); v.uc2 = *(const u32x4*)(zr + 768 + 512 + ch0); }
    return v;
}
__device__ __forceinline__ void conv_store(const ConvLd& v, const float* convw, bf16_t* YA, int it) {
    const int tok = it >> 5, ch0 = (it & 31) * 8;
    const unsigned B[4] = {v.bc.x, v.bc.y, v.bc.z, v.bc.w}, C0[4] = {v.cc0.x, v.cc0.y, v.cc0.z, v.cc0.w}, U0[4] = {v.uc0.x, v.uc0.y, v.uc0.z, v.uc0.w},
                   C1[4] = {v.cc1.x, v.cc1.y, v.cc1.z, v.cc1.w}, U1[4] = {v.uc1.x, v.uc1.y, v.uc1.z, v.uc1.w}, C2[4] = {v.cc2.x, v.cc2.y, v.cc2.z, v.cc2.w}, U2[4] = {v.uc2.x, v.uc2.y, v.uc2.z, v.uc2.w};
    const f32x4 wa0 = *(const f32x4*)(convw + ch0), wa1 = *(const f32x4*)(convw + ch0 + 4), wb0 = *(const f32x4*)(convw + 256 + ch0), wb1 = *(const f32x4*)(convw + 256 + ch0 + 4),
                wc0 = *(const f32x4*)(convw + 512 + ch0), wc1 = *(const f32x4*)(convw + 512 + ch0 + 4);
    const float W0[8] = {wa0.x, wa0.y, wa0.z, wa0.w, wa1.x, wa1.y, wa1.z, wa1.w}, W1[8] = {wb0.x, wb0.y, wb0.z, wb0.w, wb1.x, wb1.y, wb1.z, wb1.w}, W2[8] = {wc0.x, wc0.y, wc0.z, wc0.w, wc1.x, wc1.y, wc1.z, wc1.w};
    unsigned ow[4];
#pragma unroll
    for (int e2 = 0; e2 < 4; ++e2) {
        const float a0 = bf_lo(C0[e2]) * bf_lo(U0[e2]) * W0[2 * e2] + bf_lo(C1[e2]) * bf_lo(U1[e2]) * W1[2 * e2] + bf_lo(C2[e2]) * bf_lo(U2[e2]) * W2[2 * e2];
        const float a1 = bf_hi(C0[e2]) * bf_hi(U0[e2]) * W0[2 * e2 + 1] + bf_hi(C1[e2]) * bf_hi(U1[e2]) * W1[2 * e2 + 1] + bf_hi(C2[e2]) * bf_hi(U2[e2]) * W2[2 * e2 + 1];
        ow[e2] = cvt_pk_bf16(bf_lo(B[e2]) * a0, bf_hi(B[e2]) * a1);
    }
#ifdef DBG_ZCONV
    ow[0] = ow[1] = ow[2] = ow[3] = 0u;
#endif
    *(u32x4*)(YA + (size_t)tok * D + 768 + ch0) = (u32x4){ow[0], ow[1], ow[2], ow[3]};
}
__device__ __forceinline__ void merge_conv(const bf16_t* Z, const bf16_t* PO01, const bf16_t* PO2, const float* LSE, const float* convw, bf16_t* YA, int S, int gtid, int nthr) {
    for (int it = gtid; it < TH * 48; it += 2 * nthr) {
        const int it2 = it + nthr; const bool two = it2 < TH * 48;
        const MergeLd m0 = merge_load(PO01, PO2, LSE, it); MergeLd m1 = m0; if (two) m1 = merge_load(PO01, PO2, LSE, it2);
        merge_store(m0, YA, it); if (two) merge_store(m1, YA, it2);
    }
    for (int it = gtid; it < TH * 32; it += 2 * nthr) {
        const int it2 = it + nthr; const bool two = it2 < TH * 32;
        const ConvLd c0 = conv_load(Z, S, it); ConvLd c1 = c0; if (two) c1 = conv_load(Z, S, it2);
        conv_store(c0, convw, YA, it); if (two) conv_store(c1, convw, YA, it2);
    }
}

#define XB_TMO      128
#define XB_XCNT(j)  (256  + 64 * (j))
#define XB_XSUB(j)  (1280 + 64 * (j))
#define XB_XGEN(j)  (2304 + 64 * (j))
#define XB_TOP      3328
#define XB_TOPGEN   3392
#define XCD_BAR_WORDS 3456
#define XB_SPIN_CAP (1u << 22)
__device__ __forceinline__ unsigned xb_ld(unsigned* p)              { return __hip_atomic_load(p, __ATOMIC_RELAXED, __HIP_MEMORY_SCOPE_AGENT); }
__device__ __forceinline__ unsigned xb_add(unsigned* p, unsigned v) { return __hip_atomic_fetch_add(p, v, __ATOMIC_RELAXED, __HIP_MEMORY_SCOPE_AGENT); }
__device__ __forceinline__ unsigned xb_xcc_id() { return (unsigned)__builtin_amdgcn_s_getreg((3 << 11) | 20) & 0xFu; }
#define XB_SPIN(cond, bar) do { unsigned _sp = 0; while (cond) { __builtin_amdgcn_s_sleep(16); \
    if ((++_sp & 255u) == 0u) { if (xb_ld(&(bar)[XB_TMO])) break; if (_sp > XB_SPIN_CAP) { atomicAdd(&(bar)[XB_TMO], 1u); break; } } } } while (0)
struct XcdBarrier { unsigned* bar; unsigned x; volatile LAS unsigned* st; };
__device__ __forceinline__ XcdBarrier xcd_barrier_post(unsigned* bar, volatile LAS unsigned* st) {
    XcdBarrier b; b.bar = bar; b.x = xb_xcc_id(); b.st = st;
    if (threadIdx.x == 0) (void)xb_add(&bar[XB_XCNT(b.x)], 1u);
    return b;
}
__device__ __forceinline__ void xcd_barrier_complete(unsigned* bar, unsigned x, unsigned& nloc, unsigned& nx) {
    const unsigned G = gridDim.x * gridDim.y * gridDim.z;
    unsigned sum, cnt, mine, sp = 0u;
    for (;;) {
        sum = 0u; cnt = 0u; mine = 0u;
#pragma unroll
        for (unsigned j = 0; j < 16; ++j) { const unsigned c = xb_ld(&bar[XB_XCNT(j)]); sum += c; cnt += (c > 0u) ? 1u : 0u; mine = (j == x) ? c : mine; }
        if (sum == G) break;
        __builtin_amdgcn_s_sleep(1);
        if ((++sp & 255u) == 0u) { if (xb_ld(&bar[XB_TMO])) break; if (sp > XB_SPIN_CAP) { atomicAdd(&bar[XB_TMO], 1u); break; } }
    }
    nloc = mine > 0u ? mine : 1u; nx = cnt > 0u ? cnt : 1u;
}
__device__ __forceinline__ void xcd_barrier(const XcdBarrier& b) {
    asm volatile("s_waitcnt vmcnt(0)" ::: "memory");
    __syncthreads();
    if (threadIdx.x == 0) {
        unsigned* bar = b.bar; asm volatile("" : "+s"(bar));
        unsigned bxx = b.x; asm volatile("" : "+s"(bxx));
        __builtin_amdgcn_s_waitcnt(0);
        unsigned nloc = b.st[0], nx = b.st[1];
        if (nloc == 0u) { xcd_barrier_complete(bar, bxx, nloc, nx); b.st[0] = nloc; b.st[1] = nx; }
        const unsigned old = xb_add(&bar[XB_XSUB(bxx)], 1u);
        const unsigned gen = old / nloc;
        if (old + 1u == (gen + 1u) * nloc) {
            __builtin_amdgcn_fence(__ATOMIC_RELEASE, "agent");
            asm volatile("s_waitcnt vmcnt(0)" ::: "memory");
            const unsigned og = xb_add(&bar[XB_TOP], 1u);
            const unsigned tg = og / nx;
            if (og + 1u == (tg + 1u) * nx) xb_add(&bar[XB_TOPGEN], 1u);
            else XB_SPIN(xb_ld(&bar[XB_TOPGEN]) == tg, bar);
            __builtin_amdgcn_fence(__ATOMIC_ACQUIRE, "agent");
            xb_add(&bar[XB_XGEN(bxx)], 1u);
            asm volatile("s_waitcnt vmcnt(0)" ::: "memory");
        } else {
            XB_SPIN(xb_ld(&bar[XB_XGEN(bxx)]) == gen, bar);
            __builtin_amdgcn_fence(__ATOMIC_ACQUIRE, "agent");
            asm volatile("s_waitcnt vmcnt(0)" ::: "memory");
        }
    }
    __syncthreads();
}

__global__ void __launch_bounds__(512, 2) mega_fwd(Params P) {
    extern __shared__ __attribute__((aligned(16))) unsigned char lds_raw[];
    cg::grid_group grid = cg::this_grid();
    LAS unsigned char* lds = (LAS unsigned char*)lds_raw;
    const int tid0 = threadIdx.x, wave0 = __builtin_amdgcn_readfirstlane(tid0 >> 6);
    const int G = gridDim.x, bx0 = blockIdx.x;
    const int ngw = G * 8, nthr = G * 512;
    int wave = wave0, bx = bx0, gw = bx0 * 8 + wave0;
    unsigned char* ws0 = P.ws;
    unsigned char* ws = ws0;

    if (tid0 < 64) ((LAS unsigned*)(lds + LDS_STAGE))[tid0] = 0u;
    if (bx0 == 0) for (int wI = tid0; wI < 4096; wI += 512) __hip_atomic_store((unsigned*)(ws + WS_BAR) + wI, 0u, __ATOMIC_RELAXED, __HIP_MEMORY_SCOPE_AGENT);
    asm volatile("s_waitcnt vmcnt(0)" ::: "memory");
    __syncthreads();
    grid.sync();
    const XcdBarrier xbar = xcd_barrier_post((unsigned*)(ws + WS_BAR), (volatile LAS unsigned*)(lds + LDS_STAGE));
    for (int rep = 0; rep < NREP(5); ++rep) { __syncthreads(); phase_weights(P, lds, gw, ngw, wave, tid0 & 63, bx * 512 + tid0, nthr); }
    row_pass(nullptr, P.in[0], (bf16_t*)P.out + 1024, (float*)(ws + WS_RS), nullptr, nullptr, 0.f, TH, gw, ngw, tid0 & 63);
    xcd_barrier(xbar);

#if REP_MASK
    for (int st = 0; st < 100; ++st) {
      const int ph = st >> 1, rep = st & 1;
      if (rep) { const int q_ = ph % 25; int kind = 15;
          if (q_ == 0) kind = 6; else { const int r_ = (q_ - 1) % 12;
              kind = (r_ == 0 || r_ == 9) ? 0 : (r_ == 1 || r_ == 3 || r_ == 7 || r_ == 10) ? 1 : (r_ == 4) ? 2 : (r_ == 6) ? 3 : ((r_ == 2 || r_ == 8 || r_ == 11) && !(r_ == 11 && q_ > 12)) ? 4 : 15; }
          if (!((REP_MASK >> kind) & 1)) continue; }
      {
#else
    for (int ph = 0; ph < 50; ++ph) {
      const int rep = 0;
      {
#endif
        int wv = wave0; asm volatile("" : "+s"(wv));
        unsigned allm = ~0u; asm volatile("" : "+s"(allm));
        int tid = wv * 64 + (int)__builtin_amdgcn_mbcnt_hi(allm, __builtin_amdgcn_mbcnt_lo(allm, 0u)); asm volatile("" : "+v"(tid));
        unsigned char* ws = ws0; asm volatile("" : "+s"(ws));
        bf16_t* WB = (bf16_t*)(ws + WS_W);
        bf16_t* XA = (bf16_t*)(ws + WS_XA);
        bf16_t* OB = (bf16_t*)(ws + WS_OB);
        bf16_t* BIG = (bf16_t*)(ws + WS_BIG);
        bf16_t* ST = (bf16_t*)(ws + WS_ST);
        bf16_t* PO2 = (bf16_t*)(ws + WS_P2);
        float* LSE = (float*)(ws + WS_OB + OB_LSE_OFF);
        float* RS = (float*)(ws + WS_RS);
        const float* gains = P.in[2];
        int bx = bx0; asm volatile("" : "+s"(bx));
        const int wave = __builtin_amdgcn_readfirstlane(tid >> 6), gw = bx * 8 + wave;
        const int lane = tid & 63, gtid = bx * 512 + tid;
        const int hf = ph / 25, q = ph % 25;
        const int S = hf ? 4096 : 2048;
        const float* xin = P.in[hf];
        float* xout = P.out + (size_t)hf * TH * D;
        bf16_t* X16 = (bf16_t*)xout + 1024;
        if (q == 0) continue;
        {
            const int l = (q - 1) / 12, r = (q - 1) % 12;
            const bf16_t* wl = WB + (size_t)l * L_ELEMS;
            const float* gl = gains + (size_t)l * 6 * D;
            if (r == 0 || r == 9) {
                pg8::Gemm g{X16, wl + (r == 0 ? L_UP1 : L_UP2), TH, NUP, D, XP}; pg8::StaticOrder So; So.init(TH, NUP, G, bx);
                pg8::EpiSwiglu E{BIG, FF};
                pg8::gemm_phase<pg8::EpiSwiglu, true>(lds, g, So, E, tid);
            } else if (r == 1 || r == 3 || r == 7 || r == 10) {
                pg8::Gemm g; pg8::EpiStore E;
                if (r == 1 || r == 10) { g = pg8::Gemm{BIG, wl + (r == 1 ? L_DN1 : L_DN2), TH, D, FF, FF}; E = pg8::EpiStore{OB, D, D, nullptr}; }
                else if (r == 3) { g = pg8::Gemm{X16, wl + L_IN, TH, NINP, D, XP}; E = pg8::EpiStore{BIG, 0, NIN, nullptr}; }
                else { g = pg8::Gemm{XA, wl + L_OUT, TH, D, D, D}; E = pg8::EpiStore{OB, D, D, nullptr}; }
                pg8::StaticOrder So; So.init(TH, g.N, G, bx);
                pg8::gemm_phase<pg8::EpiStore, true>(lds, g, So, E, tid);
            } else if (r == 2 || r == 8 || r == 11) {
                const float* gpost = gl + (r == 2 ? 1 : r == 8 ? 3 : 5) * D;
                const bool fin = (r == 11 && l + 1 == DEPTH);
                row_pass(OB, (l == 0 && r == 2 && rep == 0) ? xin : nullptr, X16, RS, fin ? xout : nullptr, gpost, rep ? 0.0f : ((r == 8) ? 1.0f : 0.5f), TH, gw, ngw, lane);
                if (fin && hf == 0) row_pass(nullptr, P.in[1], (bf16_t*)(P.out + (size_t)TH * D) + 1024, RS, nullptr, nullptr, 0.f, TH, gw, ngw, lane);
            } else {
                volatile LAS float* lgs = (volatile LAS float*)(lds + LDS_STAGE + 128);
                if (tid < 8) lgs[tid] = -__log2f(1.0f + __expf(-(P.in[8] + l * 8)[tid]));
                __syncthreads();
                if (r == 4) {
                    { AttnStage ast = attn_load(BIG, S, bx % 4608, tid, wave, lane);
                      for (int it = bx; it < 4608; it += G) {
                        const int p = it / 1536, itn = (it + G < 4608) ? it + G : it;
                        ast = attn_item(lds, BIG, (p < 2) ? OB + (size_t)p * TH * 384 : PO2, LSE + (size_t)p * TH * 6, S, it, itn, ast, tid, wave, lane);
                      } }
                    for (int it = bx; it < 1024; it += G) {
                        const int h = it & 3;
                        const float lgf2 = lgs[h], lgb2 = lgs[4 + h];
                        retkv_item(lds, BIG, ST, it, lgf2, lgb2, tid, wave, lane);
                    }
                } else if (r == 5) {
                    ret_scan(ST, S, lgs, gtid, nthr);
                    __syncthreads();
                } else {
                    for (int it = bx; it < 1024; it += G) {
                        const int h = it & 3;
                        const float lgf2 = lgs[h], lgb2 = lgs[4 + h];
                        retout_item(lds, BIG, ST, XA, it, lgf2, lgb2, tid, wave, lane);
                    }
                    merge_conv(BIG, OB, PO2, LSE, P.in[7] + l * 768, XA, S, gtid, nthr);
                }
            }
        }
      }
        for (int rp = 0; rp < NREP(7); ++rp) xcd_barrier(xbar);
    }
}

extern "C" void kernel_launch(void* const* d_in, const int* in_sizes, int n_in, void* d_out, int out_size, void* d_ws, size_t ws_size, hipStream_t stream) {
    static int grid = 0;
    if (grid == 0) {
        if (n_in != 13 || ws_size < WS_TOTAL) { fprintf(stderr, "kernel_launch: need 13 inputs and >= %zu bytes of workspace (got %d, %zu)\n", (size_t)WS_TOTAL, n_in, ws_size); grid = -1; return; }
        int dev = 0, cus = 0, per_cu = 0;
        hipGetDevice(&dev);
        hipDeviceGetAttribute(&cus, hipDeviceAttributeMultiprocessorCount, dev);
        hipFuncSetAttribute((const void*)mega_fwd, hipFuncAttributeMaxDynamicSharedMemorySize, LDS_BYTES);
        hipOccupancyMaxActiveBlocksPerMultiprocessor(&per_cu, (const void*)mega_fwd, 512, LDS_BYTES);
        if (per_cu < 1) per_cu = 1;
        grid = cus * per_cu;
        fprintf(stderr, "kernel_launch: grid %d (cus %d x %d)\n", grid, cus, per_cu);
    }
    if (grid < 0) return;
    Params p{};
    for (int i = 0; i < 13; ++i) p.in[i] = (const float*)d_in[i];
    p.out = (float*)d_out; p.ws = (unsigned char*)d_ws;
    void* args[] = {&p};
    hipError_t e = hipLaunchCooperativeKernel((const void*)mega_fwd, dim3(grid), dim3(512), args, LDS_BYTES, stream);
    if (e != hipSuccess) fprintf(stderr, "cooperative launch failed: %s (grid %d)\n", hipGetErrorString(e), grid);
}
```

```cpp
#ifndef REP_MASK
#define REP_MASK 0
#endif
#define NREP(k) ((((REP_MASK) >> (k)) & 1) + 1)
#include <hip/hip_runtime.h>
#include <hip/hip_cooperative_groups.h>
#include <cstdio>
#include <cstdint>
namespace cg = cooperative_groups;

#define LAS __attribute__((address_space(3)))
typedef unsigned short bf16_t;
typedef short bf16x8 __attribute__((ext_vector_type(8)));
typedef short bf16x4 __attribute__((ext_vector_type(4)));
typedef float f32x4 __attribute__((ext_vector_type(4)));
typedef unsigned u32x4 __attribute__((ext_vector_type(4)));
typedef unsigned u32x2 __attribute__((ext_vector_type(2)));

constexpr int D = 1024, FF = 2816, NUP = 5632, NIN = 3456, NINP = 3584, TH = 32768, ZS = 3456, DEPTH = 2;
constexpr float EPS = 1e-6f;
constexpr float LOG2E = 1.4426950408889634f;
constexpr size_t ZA_OFF = 0, ZR_OFF = (size_t)TH * 1152, ZC_OFF = (size_t)TH * 2688;
constexpr size_t L_UP1 = 0, L_DN1 = 5767168, L_IN = 8650752, L_OUT = 12320768, L_UP2 = 13369344, L_DN2 = 19136512, L_ELEMS = 22020096;
constexpr size_t WS_W = 0, WS_XA = 2 * L_ELEMS * 2, WS_OB = WS_XA + (size_t)TH * D * 2, WS_BIG = WS_OB + (size_t)TH * D * 2,
                 WS_ST = WS_BIG + (size_t)TH * ZS * 2, WS_P2 = WS_ST + (size_t)256 * 4 * 2 * 9216 * 2, WS_END = WS_P2 + (size_t)TH * 384 * 2;
constexpr size_t WS_BAR = WS_END, WS_RS = WS_BAR + 16384, WS_TOTAL = WS_RS + (size_t)TH * 4;
constexpr size_t OB_LSE_OFF = (size_t)2 * TH * 384 * 2;
constexpr int LDS_STAGE = 131072, LDS_BYTES = LDS_STAGE + 256;

__device__ __forceinline__ unsigned cvt_pk_bf16(float lo, float hi) { unsigned r; asm volatile("v_cvt_pk_bf16_f32 %0, %1, %2" : "=v"(r) : "v"(lo), "v"(hi)); return r; }
__device__ __forceinline__ float bf_lo(unsigned w) { return __uint_as_float(w << 16); }
__device__ __forceinline__ float bf_hi(unsigned w) { return __uint_as_float(w & 0xffff0000u); }
__device__ __forceinline__ float wave_sum(float v) {
#pragma unroll
    for (int o = 1; o < 64; o <<= 1) v += __shfl_xor(v, o);
    return v;
}
__device__ __forceinline__ float fexp2(float x) { return __builtin_amdgcn_exp2f(x); }
template <int O> __device__ __forceinline__ float shx(float v, int lane) {
    if constexpr (O < 32) return __int_as_float(__builtin_amdgcn_ds_swizzle(__float_as_int(v), 0x1f | (O << 10)));
    else return __int_as_float(__builtin_amdgcn_ds_bpermute((lane ^ 32) << 2, __float_as_int(v)));
}
__device__ __forceinline__ float shx(float v, int o, int lane) { return __int_as_float(__builtin_amdgcn_ds_bpermute((lane ^ o) << 2, __float_as_int(v))); }

namespace pg8 {
constexpr int BM = 256, BK = 64, HALF = 128, HTB = HALF * BK * 2, STAGE_BYTES = 8 * HTB, NXCD = 8, WGM = 8;
__host__ __device__ __forceinline__ int lds_byte(int r, int c) { const int st = (r >> 4) * 2 + (c >> 5), rr = r & 15, cc = c & 31, ob = rr * 64 + cc * 2; return st * 1024 + (ob ^ (((ob >> 9) & 1) << 5)); }
__host__ __device__ __forceinline__ void stage_rc(int b, int& R, int& C) { const int st = b / 1024, sb = b % 1024, swz = sb ^ (((sb >> 9) & 1) << 5); R = (st >> 1) * 16 + swz / 64; C = (st & 1) * 32 + (swz % 64) / 2; }
__host__ __device__ __forceinline__ int perm32(int rho) { const int n = rho >> 4, i = rho & 15; return 8 * (i >> 2) + 4 * n + (i & 3); }

struct Unit { int pm, pn; };
struct Gemm { const bf16_t* A; const bf16_t* Bt; int M, N, K, lda; };

struct StaticOrder {
    int nM, nN, nwg, G, c;
    __device__ void init(int M, int N, int G_, int c_) { nM = M / BM; nN = N / BM; nwg = nM * nN; G = G_; c = c_; }
    __device__ bool next(int i, Unit& u) const {
        const long L = (long)i * G + c; if (L >= nwg) return false;
        int wgid = (int)L; { const int q = nwg / NXCD, r = nwg % NXCD, xcd = wgid % NXCD, off = wgid / NXCD; wgid = (xcd < r ? xcd * (q + 1) : r * (q + 1) + (xcd - r) * q) + off; }
        const int nig = WGM * nN, gid = wgid / nig, fm = gid * WGM, gsz = (nM - fm) < WGM ? (nM - fm) : WGM;
        u.pm = fm + ((wgid % nig) % gsz); u.pn = (wgid % nig) / gsz; return true;
    }
};

struct EpiSwiglu {
    static constexpr bool PERM = true;
    bf16_t* H; int ldh;
    __device__ __forceinline__ void operator()(const f32x4 (&acc)[2][2][4][2], const Unit& u, int wr, int wc, int fr, int fq) const {
        const int row0 = u.pm * BM + wr * 64 + fr, col0 = u.pn * HALF + wc * 32 + 8 * fq;
#pragma unroll
        for (int ai = 0; ai < 2; ++ai)
#pragma unroll
            for (int m = 0; m < 4; ++m) {
                bf16_t* p = H + (size_t)(row0 + ai * HALF + m * 16) * ldh + col0;
                float v[8];
#pragma unroll
                for (int n = 0; n < 2; ++n)
#pragma unroll
                    for (int j = 0; j < 4; ++j) { const float g = acc[ai][0][m][n][j], up = acc[ai][1][m][n][j];
                        v[n * 4 + j] = g * __builtin_amdgcn_rcpf(1.0f + __expf(-g)) * up; }
                u32x4 w; w.x = cvt_pk_bf16(v[0], v[1]); w.y = cvt_pk_bf16(v[2], v[3]); w.z = cvt_pk_bf16(v[4], v[5]); w.w = cvt_pk_bf16(v[6], v[7]);
                *(u32x4*)p = w;
            }
    }
};
struct EpiStore {
    static constexpr bool PERM = true;
    bf16_t* O; int ldc; int ncols; const float* rs;
    __device__ __forceinline__ void operator()(const f32x4 (&acc)[2][2][4][2], const Unit& u, int wr, int wc, int fr, int fq) const {
        const int row0 = u.pm * BM + wr * 64 + fr, col0 = u.pn * BM + wc * 32 + 8 * fq;
        unsigned base[2];
#pragma unroll
        for (int bj = 0; bj < 2; ++bj) { const int c = col0 + bj * HALF;
            if (ldc) { base[bj] = (unsigned)c; }
            else if (c < 1152) { const int w3 = c / 384, rm = c % 384, h = rm >> 6, e = rm & 63; base[bj] = (unsigned)(ZA_OFF + (size_t)h * TH * 192 + w3 * 64 + e) | 1u; }
            else if (c < 2688) { const int cc = c - 1152, w4 = cc / 384, rm = cc % 384, h = rm / 96, e = rm % 96; base[bj] = (unsigned)(ZR_OFF + (size_t)h * TH * 384 + w4 * 96 + e) | 2u; }
            else { base[bj] = (unsigned)(ZC_OFF + (size_t)(c - 2688)) | 3u; } }
#pragma unroll
        for (int ai = 0; ai < 2; ++ai)
#pragma unroll
            for (int m = 0; m < 4; ++m) {
                const unsigned row = (unsigned)(row0 + ai * HALF + m * 16);
#pragma unroll
                for (int bj = 0; bj < 2; ++bj) {
                    const f32x4 v0 = acc[ai][bj][m][0], v1 = acc[ai][bj][m][1];
                    u32x4 w; w.x = cvt_pk_bf16(v0[0], v0[1]); w.y = cvt_pk_bf16(v0[2], v0[3]); w.z = cvt_pk_bf16(v1[0], v1[1]); w.w = cvt_pk_bf16(v1[2], v1[3]);
                    const unsigned code = base[bj] & 3u, pitch = code ? (96u << code) : (unsigned)ldc;
                    if (col0 + bj * HALF < ncols) *(u32x4*)(O + (size_t)((base[bj] & ~3u) + row * pitch)) = w;
                }
            }
    }
};

template <class Epi, bool ALIGN_EPI, bool SP2 = true>
__device__ __forceinline__ void gemm_phase(LAS unsigned char* lds, const Gemm g, const StaticOrder& S, const Epi& E, const int tid) {
    const int wid = __builtin_amdgcn_readfirstlane(tid >> 6), lane = tid & 63, wr = wid >> 2, wc = wid & 3, fr = lane & 15, fq = lane >> 4;
    const int K = g.K, nt = K / BK;
    unsigned voffA[2], voffB[2];
#pragma unroll
    for (int i = 0; i < 2; ++i) { int R, C; stage_rc(tid * 16 + i * 8192, R, C); const int Rb = Epi::PERM ? ((R & ~31) + perm32(R & 31)) : R;
        voffA[i] = (unsigned)(R * g.lda + C) * 2u; voffB[i] = (unsigned)(Rb * K + C) * 2u; }
    const size_t kstep = (size_t)(BK * 2);
    const size_t hstep = (size_t)HALF * K * 2;
    const size_t tstep = 2 * hstep;
    const size_t hstepA = (size_t)HALF * g.lda * 2, tstepA = 2 * hstepA;
    const unsigned ldsw = (unsigned)wid * 1024u;
    const int aoff = lds_byte(wr * 64 + fr, fq * 8), boff = lds_byte(wc * 32 + fr, fq * 8);
#define PG8_SA(b, h) (((b) * 2 + (h)) * HTB)
#define PG8_SB(b, h) ((4 + (b) * 2 + (h)) * HTB)
#define PG8_STAGE(bufoff, gbase, voff) do { _Pragma("unroll") for (int _i = 0; _i < 2; ++_i) \
        __builtin_amdgcn_global_load_lds((const unsigned*)((const char*)(gbase) + (voff)[_i]), (LAS unsigned*)(lds + (bufoff) + ldsw + _i * 8192), 16, 0, 0); } while (0)
#define PG8_LDA(dst, b, h) do { _Pragma("unroll") for (int m = 0; m < 4; ++m) _Pragma("unroll") for (int k = 0; k < 2; ++k) dst[m][k] = *(const LAS bf16x8*)(lds + PG8_SA(b, h) + aoff + m * 2048 + k * 1024); } while (0)
#define PG8_LDB(dst, b, h) do { _Pragma("unroll") for (int n = 0; n < 2; ++n) _Pragma("unroll") for (int k = 0; k < 2; ++k) dst[n][k] = *(const LAS bf16x8*)(lds + PG8_SB(b, h) + boff + n * 2048 + k * 1024); } while (0)
#define PG8_MMA(ai, bj, At, Bt) do { __builtin_amdgcn_s_setprio(1); _Pragma("unroll") for (int m = 0; m < 4; ++m) _Pragma("unroll") for (int n = 0; n < 2; ++n) _Pragma("unroll") for (int k = 0; k < 2; ++k) \
        acc[ai][bj][m][n] = __builtin_amdgcn_mfma_f32_16x16x32_bf16(Bt[n][k], At[m][k], acc[ai][bj][m][n], 0, 0, 0); __builtin_amdgcn_s_setprio(0); } while (0)
#define PG8_WAIT_V(n) asm volatile("s_waitcnt vmcnt(" #n ")" ::: "memory")
#define PG8_WAIT_L(n) asm volatile("s_waitcnt lgkmcnt(" #n ")" ::: "memory")
#define PG8_BAR __builtin_amdgcn_s_barrier()
#define PG8_SCHED __builtin_amdgcn_sched_barrier(0)
    Unit cur, nxt; int ui = 0;
    if (!S.next(0, cur)) return;
    f32x4 acc[2][2][4][2];
#pragma unroll
    for (int a = 0; a < 2; ++a)
#pragma unroll
        for (int b = 0; b < 2; ++b)
#pragma unroll
            for (int m = 0; m < 4; ++m)
#pragma unroll
                for (int n = 0; n < 2; ++n) acc[a][b][m][n] = (f32x4){0.f, 0.f, 0.f, 0.f};
    bf16x8 At[4][2], B0[2][2], B1[2][2];
    const char* cA = (const char*)g.A + (size_t)cur.pm * tstepA; const char* cB = (const char*)g.Bt + (size_t)cur.pn * tstep;
    if constexpr (SP2) {
    PG8_STAGE(PG8_SB(0, 0), cB, voffB); PG8_STAGE(PG8_SB(0, 1), cB + hstep, voffB); PG8_STAGE(PG8_SA(0, 0), cA, voffA); PG8_STAGE(PG8_SA(0, 1), cA + hstepA, voffA);
    if (wr == 1) PG8_BAR;
    PG8_WAIT_V(2); PG8_BAR;
    PG8_STAGE(PG8_SB(1, 0), cB + kstep, voffB); PG8_STAGE(PG8_SA(1, 0), cA + kstep, voffA); PG8_STAGE(PG8_SB(1, 1), cB + hstep + kstep, voffB);
    PG8_WAIT_V(6); PG8_BAR;
    } else {
    PG8_STAGE(PG8_SB(0, 0), cB, voffB); PG8_STAGE(PG8_SA(0, 0), cA, voffA); PG8_STAGE(PG8_SB(0, 1), cB + hstep, voffB); PG8_STAGE(PG8_SA(0, 1), cA + hstepA, voffA);
    if (wr == 1) PG8_BAR;
    PG8_WAIT_V(4); PG8_BAR;
    PG8_STAGE(PG8_SB(1, 0), cB + kstep, voffB); PG8_STAGE(PG8_SA(1, 0), cA + kstep, voffA); PG8_STAGE(PG8_SB(1, 1), cB + hstep + kstep, voffB);
    PG8_WAIT_V(6); PG8_BAR;
    }
    for (;;) {
        const bool has_next = S.next(ui + 1, nxt);
        const char* nA = has_next ? (const char*)g.A + (size_t)nxt.pm * tstepA : cA; const char* nB = has_next ? (const char*)g.Bt + (size_t)nxt.pn * tstep : cB;
        for (int t = 0; t < nt; t += 2) {
            const bool last = (t == nt - 2);
            const char* a1 = cA + (size_t)(t + 1) * kstep;
            const char* a2 = last ? nA : cA + (size_t)(t + 2) * kstep; const char* b2 = last ? nB : cB + (size_t)(t + 2) * kstep;
            const char* a3 = a2 + kstep; const char* b3 = b2 + kstep;
            if constexpr (!SP2) {
            PG8_LDB(B0, 0, 0); PG8_SCHED; PG8_LDA(At, 0, 0); PG8_STAGE(PG8_SA(1, 1), a1 + hstepA, voffA);
            PG8_WAIT_L(8); PG8_BAR; PG8_WAIT_L(0); PG8_MMA(0, 0, At, B0); PG8_BAR; PG8_SCHED;
            PG8_LDB(B1, 0, 1); PG8_STAGE(PG8_SB(0, 0), b2, voffB);
            PG8_BAR; PG8_WAIT_L(0); PG8_MMA(0, 1, At, B1); PG8_BAR;
            PG8_LDA(At, 0, 1); PG8_STAGE(PG8_SA(0, 0), a2, voffA);
            PG8_BAR; PG8_WAIT_L(0); PG8_MMA(1, 0, At, B0); PG8_BAR; PG8_SCHED;
            PG8_STAGE(PG8_SB(0, 1), b2 + hstep, voffB);
            PG8_WAIT_V(6); PG8_BAR; PG8_MMA(1, 1, At, B1); PG8_BAR;
            PG8_LDB(B0, 1, 0); PG8_SCHED; PG8_LDA(At, 1, 0); PG8_STAGE(PG8_SA(0, 1), a2 + hstepA, voffA);
            PG8_WAIT_L(8); PG8_BAR; PG8_WAIT_L(0); PG8_MMA(0, 0, At, B0); PG8_BAR; PG8_SCHED;
            PG8_LDB(B1, 1, 1); PG8_STAGE(PG8_SB(1, 0), b3, voffB);
            PG8_BAR; PG8_WAIT_L(0); PG8_MMA(0, 1, At, B1); PG8_BAR;
            PG8_LDA(At, 1, 1); PG8_STAGE(PG8_SA(1, 0), a3, voffA);
            PG8_BAR; PG8_WAIT_L(0); PG8_MMA(1, 0, At, B0); PG8_BAR; PG8_SCHED;
            PG8_STAGE(PG8_SB(1, 1), b3 + hstep, voffB);
            PG8_WAIT_V(6); PG8_BAR; PG8_MMA(1, 1, At, B1); PG8_BAR;
            } else {
            PG8_LDB(B0, 0, 0); PG8_LDB(B1, 0, 1); PG8_SCHED; PG8_LDA(At, 0, 0); PG8_STAGE(PG8_SA(1, 1), a1 + hstepA, voffA);
            PG8_WAIT_V(8); PG8_WAIT_L(0); PG8_BAR; PG8_MMA(0, 0, At, B0); PG8_MMA(0, 1, At, B1); PG8_BAR; PG8_SCHED;
            PG8_LDA(At, 0, 1); PG8_STAGE(PG8_SB(0, 0), b2, voffB); PG8_STAGE(PG8_SB(0, 1), b2 + hstep, voffB); PG8_STAGE(PG8_SA(0, 0), a2, voffA);
            PG8_WAIT_V(8); PG8_WAIT_L(0); PG8_BAR; PG8_MMA(1, 0, At, B0); PG8_MMA(1, 1, At, B1); PG8_BAR; PG8_SCHED;
            PG8_LDB(B0, 1, 0); PG8_LDB(B1, 1, 1); PG8_SCHED; PG8_LDA(At, 1, 0); PG8_STAGE(PG8_SA(0, 1), a2 + hstepA, voffA);
            PG8_WAIT_V(8); PG8_WAIT_L(0); PG8_BAR; PG8_MMA(0, 0, At, B0); PG8_MMA(0, 1, At, B1); PG8_BAR; PG8_SCHED;
            PG8_LDA(At, 1, 1); PG8_STAGE(PG8_SB(1, 0), b3, voffB); PG8_STAGE(PG8_SB(1, 1), b3 + hstep, voffB); PG8_STAGE(PG8_SA(1, 0), a3, voffA);
            PG8_WAIT_V(8); PG8_WAIT_L(0); PG8_BAR; PG8_MMA(1, 0, At, B0); PG8_MMA(1, 1, At, B1); PG8_BAR; PG8_SCHED;
            }
        }
        if constexpr (ALIGN_EPI) { if (wr == 0) PG8_BAR; }
        E(acc, cur, wr, wc, fr, fq);
        if (!has_next) break;
#pragma unroll
        for (int a = 0; a < 2; ++a)
#pragma unroll
            for (int b = 0; b < 2; ++b)
#pragma unroll
                for (int m = 0; m < 4; ++m)
#pragma unroll
                    for (int n = 0; n < 2; ++n) acc[a][b][m][n] = (f32x4){0.f, 0.f, 0.f, 0.f};
        cur = nxt; cA = nA; cB = nB; ++ui;
        if constexpr (ALIGN_EPI) { if (wr == 1) PG8_BAR; }
    }
    PG8_WAIT_V(0);
    if constexpr (!ALIGN_EPI) { if (wr == 0) PG8_BAR; }
    PG8_BAR;
#undef PG8_SA
#undef PG8_SB
#undef PG8_STAGE
#undef PG8_LDA
#undef PG8_LDB
#undef PG8_MMA
#undef PG8_WAIT_V
#undef PG8_WAIT_L
#undef PG8_BAR
#undef PG8_SCHED
}
}

struct Params { const float* in[13]; float* out; unsigned char* ws; };

__device__ __forceinline__ void transpose_item(const float* W, int K, int N, bf16_t* WT, int mode, LAS float* scr, int item, int lane, const float* gk) {
    const int nblk = N / 32, kb = item / nblk, nb = item % nblk, k0 = 64 * kb, n0 = 32 * nb;
    const int r0 = (mode == 0) ? n0 : ((n0 >> 7) * 256 + (n0 & 127) + (mode == 2 ? 128 : 0));
    f32x4 wv[8];
#pragma unroll
    for (int i = 0; i < 8; ++i) { const int kk = 8 * i + (lane >> 3); wv[i] = *(const f32x4*)(W + (size_t)(k0 + kk) * N + n0 + 4 * (lane & 7)); }
#pragma unroll
    for (int i = 0; i < 8; ++i) { const int kk = 8 * i + (lane >> 3); const float gg = gk ? gk[k0 + kk] : 1.0f; LAS float* d = scr + kk * 33 + 4 * (lane & 7);
        d[0] = wv[i].x * gg; d[1] = wv[i].y * gg; d[2] = wv[i].z * gg; d[3] = wv[i].w * gg; }
    asm volatile("s_waitcnt lgkmcnt(0)" ::: "memory");
    const int c = lane & 7;
#pragma unroll
    for (int j = 0; j < 4; ++j) { const int n = (lane >> 3) + 8 * j; const LAS float* s = scr + (8 * c) * 33 + n;
        u32x4 o; o.x = cvt_pk_bf16(s[0 * 33], s[1 * 33]); o.y = cvt_pk_bf16(s[2 * 33], s[3 * 33]); o.z = cvt_pk_bf16(s[4 * 33], s[5 * 33]); o.w = cvt_pk_bf16(s[6 * 33], s[7 * 33]);
        *(u32x4*)(WT + (size_t)(r0 + n) * K + k0 + 8 * c) = o; }
    asm volatile("s_waitcnt lgkmcnt(0)" ::: "memory");
}

__device__ __forceinline__ void phase_weights(const Params& P, LAS unsigned char* lds, int gw, int ngw, int wave, int lane, int gtid, int nthr) {
    LAS float* scr = (LAS float*)(lds + wave * 8448);
    bf16_t* WB = (bf16_t*)(P.ws + WS_W);
    constexpr int I_G = 16 * 88, I_D = 44 * 32, I_I = 16 * 108, I_O = 16 * 32;
    constexpr int PER_LAYER = 6 * I_G + I_I + I_O;
    static_assert(I_G == I_D, "");
    for (int it = gw; it < DEPTH * PER_LAYER; it += ngw) {
        const int l = it / PER_LAYER; int r = it % PER_LAYER;
        bf16_t* wl = WB + (size_t)l * L_ELEMS; const float* gl = P.in[2] + (size_t)l * 6 * D;
        if (r < I_G) { transpose_item(P.in[3] + (size_t)l * D * FF, D, FF, wl + L_UP1, 1, scr, r, lane, gl); continue; } r -= I_G;
        if (r < I_G) { transpose_item(P.in[4] + (size_t)l * D * FF, D, FF, wl + L_UP1, 2, scr, r, lane, gl); continue; } r -= I_G;
        if (r < I_D) { transpose_item(P.in[5] + (size_t)l * D * FF, FF, D, wl + L_DN1, 0, scr, r, lane, nullptr); continue; } r -= I_D;
        if (r < I_I) { transpose_item(P.in[6] + (size_t)l * D * NIN, D, NIN, wl + L_IN, 0, scr, r, lane, gl + 2 * D); continue; } r -= I_I;
        if (r < I_O) { transpose_item(P.in[9] + (size_t)l * D * D, D, D, wl + L_OUT, 0, scr, r, lane, nullptr); continue; } r -= I_O;
        if (r < I_G) { transpose_item(P.in[10] + (size_t)l * D * FF, D, FF, wl + L_UP2, 1, scr, r, lane, gl + 4 * D); continue; } r -= I_G;
        if (r < I_G) { transpose_item(P.in[11] + (size_t)l * D * FF, D, FF, wl + L_UP2, 2, scr, r, lane, gl + 4 * D); continue; } r -= I_G;
        transpose_item(P.in[12] + (size_t)l * D * FF, FF, D, wl + L_DN2, 0, scr, r, lane, nullptr);
    }
    for (int v = gtid; v < DEPTH * 16384; v += nthr) { const int l = v / 16384, o = v % 16384;
        *(u32x4*)(WB + (size_t)l * L_ELEMS + L_IN + (size_t)NIN * D + (size_t)o * 8) = (u32x4){0u, 0u, 0u, 0u}; }
}

constexpr int RP = 4, XP = 2048;
__device__ __forceinline__ void row_pass(const bf16_t* OB, const float* x32, bf16_t* X16, float* RS, float* out32, const float* gpost, float cres, int rows, int gw, int ngw, int lane) {
    f32x4 gpo[4];
#pragma unroll
    for (int j = 0; j < 4; ++j) gpo[j] = OB ? ((const f32x4*)gpost)[lane + 64 * j] : (f32x4){0.f, 0.f, 0.f, 0.f};
    for (int row0 = gw; row0 < rows; row0 += RP * ngw) {
        f32x4 xv[RP][4]; u32x2 ow[RP][4];
#pragma unroll
        for (int k = 0; k < RP; ++k) { const size_t row = (size_t)row0 + (size_t)k * ngw;
            if (x32) { const f32x4* xr = (const f32x4*)(x32 + row * D) + lane;
#pragma unroll
                for (int j = 0; j < 4; ++j) xv[k][j] = __builtin_nontemporal_load(xr + 64 * j); }
            else { const u32x2* xr = (const u32x2*)(X16 + row * XP) + lane;
#pragma unroll
                for (int j = 0; j < 4; ++j) { const u32x2 w = xr[64 * j]; xv[k][j] = (f32x4){bf_lo(w.x), bf_hi(w.x), bf_lo(w.y), bf_hi(w.y)}; }
                const float ri = RS[row];
#pragma unroll
                for (int j = 0; j < 4; ++j) xv[k][j] = xv[k][j] * ri; }
            if (OB) { const u32x2* orow = (const u32x2*)(OB + row * D) + lane;
#pragma unroll
                for (int j = 0; j < 4; ++j) ow[k][j] = __builtin_nontemporal_load(orow + 64 * j); } }
        if (OB) {
            float ss[RP];
#pragma unroll
            for (int k = 0; k < RP; ++k) { ss[k] = 0.f;
#pragma unroll
                for (int j = 0; j < 4; ++j) { const float a = bf_lo(ow[k][j].x), b = bf_hi(ow[k][j].x), c = bf_lo(ow[k][j].y), d = bf_hi(ow[k][j].y); ss[k] += (a * a + b * b) + (c * c + d * d); } }
#pragma unroll
            for (int k = 0; k < RP; ++k) ss[k] += shx<1>(ss[k], lane);
#pragma unroll
            for (int k = 0; k < RP; ++k) ss[k] += shx<2>(ss[k], lane);
#pragma unroll
            for (int k = 0; k < RP; ++k) ss[k] += shx<4>(ss[k], lane);
#pragma unroll
            for (int k = 0; k < RP; ++k) ss[k] += shx<8>(ss[k], lane);
#pragma unroll
            for (int k = 0; k < RP; ++k) ss[k] += shx<16>(ss[k], lane);
#pragma unroll
            for (int k = 0; k < RP; ++k) ss[k] += shx<32>(ss[k], lane);
#pragma unroll
            for (int k = 0; k < RP; ++k) { const float rs = rsqrtf(ss[k] * (1.f / D) + EPS) * cres;
#pragma unroll
                for (int j = 0; j < 4; ++j) { const f32x4 ov = (f32x4){bf_lo(ow[k][j].x), bf_hi(ow[k][j].x), bf_lo(ow[k][j].y), bf_hi(ow[k][j].y)};
                    xv[k][j] = xv[k][j] + ov * gpo[j] * rs; } }
        }
        if (out32) {
#pragma unroll
            for (int k = 0; k < RP; ++k) { const size_t row = (size_t)row0 + (size_t)k * ngw; f32x4* xo = (f32x4*)(out32 + row * D) + lane;
#pragma unroll
                for (int j = 0; j < 4; ++j) xo[64 * j] = xv[k][j]; }
        } else {
            float ss[RP];
#pragma unroll
            for (int k = 0; k < RP; ++k) { ss[k] = 0.f;
#pragma unroll
                for (int j = 0; j < 4; ++j) ss[k] += (xv[k][j].x * xv[k][j].x + xv[k][j].y * xv[k][j].y) + (xv[k][j].z * xv[k][j].z + xv[k][j].w * xv[k][j].w); }
#pragma unroll
            for (int k = 0; k < RP; ++k) ss[k] += shx<1>(ss[k], lane);
#pragma unroll
            for (int k = 0; k < RP; ++k) ss[k] += shx<2>(ss[k], lane);
#pragma unroll
            for (int k = 0; k < RP; ++k) ss[k] += shx<4>(ss[k], lane);
#pragma unroll
            for (int k = 0; k < RP; ++k) ss[k] += shx<8>(ss[k], lane);
#pragma unroll
            for (int k = 0; k < RP; ++k) ss[k] += shx<16>(ss[k], lane);
#pragma unroll
            for (int k = 0; k < RP; ++k) ss[k] += shx<32>(ss[k], lane);
#pragma unroll
            for (int k = 0; k < RP; ++k) { const size_t row = (size_t)row0 + (size_t)k * ngw;
                const float ms = ss[k] * (1.f / D) + EPS, rs = rsqrtf(ms);
                if (lane == 0) RS[row] = ms * rs;
                u32x2* ao = (u32x2*)(X16 + row * XP) + lane;
#pragma unroll
                for (int j = 0; j < 4; ++j) { const f32x4 v = xv[k][j] * rs; u32x2 w; w.x = cvt_pk_bf16(v.x, v.y); w.y = cvt_pk_bf16(v.z, v.w); ao[64 * j] = w; } }
        }
    }
}

constexpr int AK_PITCH = 144, AV_PITCH = 528, AK_BYTES = 256 * AK_PITCH;
struct AttnStage { u32x4 k[4], v[4]; bf16x8 q[2]; };
__device__ __forceinline__ AttnStage attn_load(const bf16_t* Z, int S, int it, int tid, int wave, int lane) {
    AttnStage st;
    const int p = it / 1536, rem = it % 1536, h = rem / 256, gb = rem % 256;
    const int bps = S >> 7, b = gb / bps, rb = gb % bps;
    const int dl = 2 * p, d = 1 << dl, L = S >> dl, nb = bps >> dl;
    const int r = rb / nb, lb = rb % nb, l0 = lb * 128;
    const int tok0 = b * S + r;
#pragma unroll
    for (int q = 0; q < 4; ++q) {
        const int idx = tid + 512 * q, i = idx >> 3, g = idx & 7, lk = l0 - 64 + i;
        st.k[q] = (u32x4){0u, 0u, 0u, 0u}; st.v[q] = (u32x4){0u, 0u, 0u, 0u};
        if (lk >= 0 && lk < L) { const bf16_t* zr = Z + ZA_OFF + ((size_t)h * TH + (size_t)(tok0 + lk * d)) * 192 + g * 8;
            st.k[q] = *(const u32x4*)(zr + 64); st.v[q] = *(const u32x4*)(zr + 128); }
    }
    const int fr = lane & 15, fq = lane >> 4;
    const size_t tq = (size_t)(tok0 + (l0 + 16 * wave + fr) * d);
#pragma unroll
    for (int kc = 0; kc < 2; ++kc) st.q[kc] = *(const bf16x8*)(Z + ZA_OFF + ((size_t)h * TH + tq) * 192 + kc * 32 + fq * 8);
    return st;
}
__device__ __forceinline__ AttnStage attn_item(LAS unsigned char* lds, const bf16_t* Z, bf16_t* PO, float* LSE, int S, int it, int itn, const AttnStage st, int tid, int wave, int lane) {
    const int p = it / 1536, rem = it % 1536, h = rem / 256, gb = rem % 256;
    const int bps = S >> 7, b = gb / bps, rb = gb % bps;
    const int dl = 2 * p, d = 1 << dl, L = S >> dl, nb = bps >> dl;
    const int r = rb / nb, lb = rb % nb, l0 = lb * 128;
    const int tok0 = b * S + r;
    LAS unsigned char* sK = lds; LAS unsigned char* sV = lds + AK_BYTES;
#pragma unroll
    for (int q = 0; q < 4; ++q) {
        const int idx = tid + 512 * q, i = idx >> 3, g = idx & 7;
        const u32x4 kv = st.k[q], vv = st.v[q];
        *(LAS u32x4*)(sK + i * AK_PITCH + g * 16) = kv;
        LAS bf16_t* vt = (LAS bf16_t*)(sV + (g * 8) * AV_PITCH + i * 2);
        vt[0 * (AV_PITCH / 2)] = (bf16_t)(vv.x & 0xffffu); vt[1 * (AV_PITCH / 2)] = (bf16_t)(vv.x >> 16);
        vt[2 * (AV_PITCH / 2)] = (bf16_t)(vv.y & 0xffffu); vt[3 * (AV_PITCH / 2)] = (bf16_t)(vv.y >> 16);
        vt[4 * (AV_PITCH / 2)] = (bf16_t)(vv.z & 0xffffu); vt[5 * (AV_PITCH / 2)] = (bf16_t)(vv.z >> 16);
        vt[6 * (AV_PITCH / 2)] = (bf16_t)(vv.w & 0xffffu); vt[7 * (AV_PITCH / 2)] = (bf16_t)(vv.w >> 16);
    }
    bf16x8 qf[2]; qf[0] = st.q[0]; qf[1] = st.q[1];
    __syncthreads();
    const AttnStage nst = attn_load(Z, S, itn, tid, wave, lane);
    const int fr = lane & 15, fq = lane >> 4;
    const int lq = l0 + 16 * wave + fr;
    const size_t tq = (size_t)(tok0 + lq * d);
    f32x4 s[9];
    __builtin_amdgcn_s_setprio(1);
#pragma unroll
    for (int kt = 0; kt < 9; ++kt) { s[kt] = (f32x4){0.f, 0.f, 0.f, 0.f};
#pragma unroll
        for (int kc = 0; kc < 2; ++kc) { const bf16x8 a = *(const LAS bf16x8*)(sK + (16 * wave + kt * 16 + fr) * AK_PITCH + (kc * 32 + fq * 8) * 2);
            s[kt] = __builtin_amdgcn_mfma_f32_16x16x32_bf16(a, qf[kc], s[kt], 0, 0, 0); } }
    __builtin_amdgcn_s_setprio(0);
    const float slope = (h == 0) ? 0.25f : (h == 1) ? 0.0625f : (h == 2) ? 0.015625f : (h == 3) ? 0.00390625f : (h == 4) ? 0.5f : 0.125f;
    const float c1 = 0.125f * LOG2E, c2 = slope * (float)d * LOG2E;
    float mx = -1e30f;
#pragma unroll
    for (int kt = 0; kt < 9; ++kt)
#pragma unroll
        for (int j = 0; j < 4; ++j) { const int ki = kt * 16 + fq * 4 + j; const int rel = ki - 64 - fr; const int ar = rel < 0 ? -rel : rel; const int lk = l0 - 64 + 16 * wave + ki;
            const bool valid = (ar <= 64) && (lk >= 0) && (lk < L);
            const float v = valid ? (s[kt][j] * c1 - c2 * (float)ar) : -1e30f; s[kt][j] = v; mx = fmaxf(mx, v); }
    mx = fmaxf(mx, shx<16>(mx, lane)); mx = fmaxf(mx, shx<32>(mx, lane));
    float sum = 0.f; bf16x4 pf[9];
#pragma unroll
    for (int kt = 0; kt < 9; ++kt) { float e[4];
#pragma unroll
        for (int j = 0; j < 4; ++j) { e[j] = fexp2(s[kt][j] - mx); sum += e[j]; }
        const unsigned w0 = cvt_pk_bf16(e[0], e[1]), w1 = cvt_pk_bf16(e[2], e[3]);
        pf[kt] = (bf16x4){(short)(w0 & 0xffffu), (short)(w0 >> 16), (short)(w1 & 0xffffu), (short)(w1 >> 16)}; }
    sum += shx<16>(sum, lane); sum += shx<32>(sum, lane);
    f32x4 o[4];
#pragma unroll
    for (int dt = 0; dt < 4; ++dt) o[dt] = (f32x4){0.f, 0.f, 0.f, 0.f};
    __builtin_amdgcn_s_setprio(1);
#pragma unroll
    for (int kt = 0; kt < 9; ++kt)
#pragma unroll
        for (int dt = 0; dt < 4; ++dt) { const bf16x4 a = *(const LAS bf16x4*)(sV + (dt * 16 + fr) * AV_PITCH + (16 * wave + kt * 16 + fq * 4) * 2);
            o[dt] = __builtin_amdgcn_mfma_f32_16x16x16bf16_1k(a, pf[kt], o[dt], 0, 0, 0); }
    __builtin_amdgcn_s_setprio(0);
    const float inv = __builtin_amdgcn_rcpf(sum);
    bf16_t* po = PO + tq * 384 + h * 64 + fq * 4;
#pragma unroll
    for (int dt = 0; dt < 4; ++dt) { u32x2 w; w.x = cvt_pk_bf16(o[dt][0] * inv, o[dt][1] * inv); w.y = cvt_pk_bf16(o[dt][2] * inv, o[dt][3] * inv); *(u32x2*)(po + dt * 16) = w; }
    if (fq == 0) LSE[tq * 6 + h] = mx + __log2f(sum);
    __syncthreads();
    return nst;
}

constexpr int RT_PITCH = 272;
constexpr int RK_PITCH = 208;
__device__ __forceinline__ void retkv_item(LAS unsigned char* lds, const bf16_t* Z, bf16_t* ST, int it, float lgf2, float lgb2, int tid, int wave, int lane) {
    const int gc = it >> 2, h = it & 3;
    const size_t t0 = (size_t)gc * 128;
    LAS unsigned char* sKf = lds; LAS unsigned char* sKb = lds + 96 * RT_PITCH; LAS unsigned char* sV = lds + 2 * 96 * RT_PITCH;
    const float ksc = 0.10206207261596577f;
#pragma unroll
    for (int q = 0; q < 3; ++q) {
        const int idx = tid + 512 * q, m = idx / 12, g = idx % 12;
        const bf16_t* zr = Z + ZR_OFF + ((size_t)h * TH + t0 + m) * 384 + g * 8;
        const u32x4 kv = *(const u32x4*)(zr + 96), vv = *(const u32x4*)(zr + 192);
        const float wf = fexp2(lgf2 * (float)(127 - m)) * ksc, wb = fexp2(lgb2 * (float)m) * ksc;
        const unsigned kw[4] = {kv.x, kv.y, kv.z, kv.w}, vw[4] = {vv.x, vv.y, vv.z, vv.w};
#pragma unroll
        for (int e2 = 0; e2 < 4; ++e2) {
            const float k0 = bf_lo(kw[e2]), k1 = bf_hi(kw[e2]);
            const unsigned pfw = cvt_pk_bf16(k0 * wf, k1 * wf), pbw = cvt_pk_bf16(k0 * wb, k1 * wb);
            const int ro = (g * 8 + 2 * e2) * RT_PITCH + m * 2;
            *(LAS bf16_t*)(sKf + ro) = (bf16_t)(pfw & 0xffffu); *(LAS bf16_t*)(sKf + ro + RT_PITCH) = (bf16_t)(pfw >> 16);
            *(LAS bf16_t*)(sKb + ro) = (bf16_t)(pbw & 0xffffu); *(LAS bf16_t*)(sKb + ro + RT_PITCH) = (bf16_t)(pbw >> 16);
            *(LAS bf16_t*)(sV + ro) = (bf16_t)(vw[e2] & 0xffffu); *(LAS bf16_t*)(sV + ro + RT_PITCH) = (bf16_t)(vw[e2] >> 16);
        }
    }
    __syncthreads();
    const int fr = lane & 15, fq = lane >> 4;
    bf16_t* stb = ST + (size_t)it * 2 * 9216;
    for (int tt = wave * 9; tt < wave * 9 + 9; ++tt) {
        const int dir = tt / 36, rm = tt % 36, dt = rm / 6, et = rm % 6;
        LAS unsigned char* sK = dir ? sKb : sKf;
        f32x4 acc = (f32x4){0.f, 0.f, 0.f, 0.f};
#pragma unroll
        for (int ks = 0; ks < 4; ++ks) {
            const bf16x8 a = *(const LAS bf16x8*)(sK + (dt * 16 + fr) * RT_PITCH + (ks * 32 + fq * 8) * 2);
            const bf16x8 bb = *(const LAS bf16x8*)(sV + (et * 16 + fr) * RT_PITCH + (ks * 32 + fq * 8) * 2);
            acc = __builtin_amdgcn_mfma_f32_16x16x32_bf16(a, bb, acc, 0, 0, 0);
        }
        asm volatile("s_nop 7\n\ts_nop 7\n\ts_nop 7" : "+v"(acc));
        u32x2 w; w.x = cvt_pk_bf16(acc[0], acc[1]); w.y = cvt_pk_bf16(acc[2], acc[3]);
        __hip_atomic_store((unsigned long long*)(stb + (size_t)dir * 9216 + (et * 16 + fr) * 96 + dt * 16 + fq * 4), (unsigned long long)w.x | ((unsigned long long)w.y << 32), __ATOMIC_RELAXED, __HIP_MEMORY_SCOPE_AGENT);
    }
    __syncthreads();
}

__device__ __forceinline__ void ret_scan(bf16_t* ST, int S, volatile LAS float* lg2, int gtid, int nthr) {
    const int nc = S >> 7, nseq = TH / S, nvec = nseq * 4 * 2 * 1152;
    for (int v = gtid; v < nvec; v += nthr) {
        const int dv = v % 1152, t2 = v / 1152, dir = t2 & 1, h = (t2 >> 1) & 3, b = t2 >> 3;
        const float gC = fexp2(lg2[dir * 4 + h] * 128.f);
        float s[8];
#pragma unroll
        for (int k = 0; k < 8; ++k) s[k] = 0.f;
        for (int i0 = 0; i0 < nc; i0 += 16) {
            u32x4 t[16];
#pragma unroll
            for (int k = 0; k < 16; ++k) { const int i = i0 + k, c = dir ? nc - 1 - i : i;
                t[k] = *(const u32x4*)(ST + ((((size_t)(b * nc + c) * 4 + h) * 2 + dir) * 9216 + dv * 8)); }
#pragma unroll
            for (int k = 0; k < 16; ++k) { const int i = i0 + k, c = dir ? nc - 1 - i : i;
                u32x4 o; o.x = cvt_pk_bf16(s[0], s[1]); o.y = cvt_pk_bf16(s[2], s[3]); o.z = cvt_pk_bf16(s[4], s[5]); o.w = cvt_pk_bf16(s[6], s[7]);
                *(u32x4*)(ST + ((((size_t)(b * nc + c) * 4 + h) * 2 + dir) * 9216 + dv * 8)) = o;
                s[0] = gC * s[0] + bf_lo(t[k].x); s[1] = gC * s[1] + bf_hi(t[k].x); s[2] = gC * s[2] + bf_lo(t[k].y); s[3] = gC * s[3] + bf_hi(t[k].y);
                s[4] = gC * s[4] + bf_lo(t[k].z); s[5] = gC * s[5] + bf_hi(t[k].z); s[6] = gC * s[6] + bf_lo(t[k].w); s[7] = gC * s[7] + bf_hi(t[k].w); }
        }
    }
}

__device__ __forceinline__ void retout_item(LAS unsigned char* lds, const bf16_t* Z, const bf16_t* ST, bf16_t* YA, int it, float lgf2, float lgb2, int tid, int wave, int lane) {
    const int gc = it >> 2, h = it & 3;
    const size_t t0 = (size_t)gc * 128;
    LAS unsigned char* sK = lds; LAS unsigned char* sV = lds + 128 * RK_PITCH; LAS unsigned char* sS = sV + 96 * RT_PITCH;
    const bf16_t* stb = ST + (size_t)it * 2 * 9216;
#pragma unroll
    for (int q = 0; q < 5; ++q) { const int c = tid + 512 * q;
        if (c < 2304) { const int dir = c / 1152, rm = c % 1152, e = rm / 12, part = rm % 12;
            *(LAS u32x4*)(sS + (dir * 96 + e) * RK_PITCH + part * 16) = *(const u32x4*)(stb + (size_t)c * 8); } }
#pragma unroll
    for (int q = 0; q < 3; ++q) {
        const int idx = tid + 512 * q, m = idx / 12, g = idx % 12;
        const bf16_t* zr = Z + ZR_OFF + ((size_t)h * TH + t0 + m) * 384 + g * 8;
        const u32x4 kv = *(const u32x4*)(zr + 96), vv = *(const u32x4*)(zr + 192);
        *(LAS u32x4*)(sK + m * RK_PITCH + g * 16) = kv;
        const unsigned vw[4] = {vv.x, vv.y, vv.z, vv.w};
#pragma unroll
        for (int e2 = 0; e2 < 4; ++e2) { const int ro = (g * 8 + 2 * e2) * RT_PITCH + m * 2;
            *(LAS bf16_t*)(sV + ro) = (bf16_t)(vw[e2] & 0xffffu); *(LAS bf16_t*)(sV + ro + RT_PITCH) = (bf16_t)(vw[e2] >> 16); }
    }
    __syncthreads();
    const int fr = lane & 15, fq = lane >> 4;
    const int n = 16 * wave + fr;
    const size_t tq = t0 + n;
    const float ksc = 0.10206207261596577f;
    bf16x8 qf[3];
#pragma unroll
    for (int ks = 0; ks < 3; ++ks) qf[ks] = *(const bf16x8*)(Z + ZR_OFF + ((size_t)h * TH + tq) * 384 + ks * 32 + fq * 8);
    f32x4 o[6];
#pragma unroll
    for (int et = 0; et < 6; ++et) o[et] = (f32x4){0.f, 0.f, 0.f, 0.f};
#pragma unroll
    for (int mt = 0; mt < 8; ++mt) {
        f32x4 s = (f32x4){0.f, 0.f, 0.f, 0.f};
#pragma unroll
        for (int ks = 0; ks < 3; ++ks) { const bf16x8 a = *(const LAS bf16x8*)(sK + (mt * 16 + fr) * RK_PITCH + (ks * 32 + fq * 8) * 2);
            s = __builtin_amdgcn_mfma_f32_16x16x32_bf16(a, qf[ks], s, 0, 0, 0); }
        float pv[4];
#pragma unroll
        for (int j = 0; j < 4; ++j) { const int mm = mt * 16 + fq * 4 + j; const int df = n - mm;
            const float dec = (df >= 0) ? fexp2(lgf2 * (float)df) : fexp2(lgb2 * (float)(-df));
            pv[j] = s[j] * ksc * dec; }
        const unsigned w0 = cvt_pk_bf16(pv[0], pv[1]), w1 = cvt_pk_bf16(pv[2], pv[3]);
        const bf16x4 pfr = (bf16x4){(short)(w0 & 0xffffu), (short)(w0 >> 16), (short)(w1 & 0xffffu), (short)(w1 >> 16)};
#pragma unroll
        for (int et = 0; et < 6; ++et) { const bf16x4 a = *(const LAS bf16x4*)(sV + (et * 16 + fr) * RT_PITCH + (mt * 16 + fq * 4) * 2);
            o[et] = __builtin_amdgcn_mfma_f32_16x16x16bf16_1k(a, pfr, o[et], 0, 0, 0); }
    }
    const float qwf = fexp2(lgf2 * (float)(n + 1)), qwb = fexp2(lgb2 * (float)(128 - n));
#pragma unroll
    for (int dir = 0; dir < 2; ++dir) {
        const float qw = dir ? qwb : qwf;
#pragma unroll
        for (int et = 0; et < 6; ++et) {
            f32x4 x = (f32x4){0.f, 0.f, 0.f, 0.f};
#pragma unroll
            for (int ks = 0; ks < 3; ++ks) { const bf16x8 a = *(const LAS bf16x8*)(sS + (dir * 96 + et * 16 + fr) * RK_PITCH + (ks * 32 + fq * 8) * 2);
                x = __builtin_amdgcn_mfma_f32_16x16x32_bf16(a, qf[ks], x, 0, 0, 0); }
#ifndef DBG_NOCROSS
            o[et] = o[et] + x * qw;
#endif
        }
    }
#ifdef DBG_SANITIZE
#pragma unroll
    for (int et = 0; et < 6; ++et)
#pragma unroll
        for (int j = 0; j < 4; ++j) o[et][j] = (fabsf(o[et][j]) < 1e30f) ? o[et][j] : 0.f;
#endif
    float sm = 0.f;
#pragma unroll
    for (int et = 0; et < 6; ++et) sm += (o[et][0] + o[et][1]) + (o[et][2] + o[et][3]);
    sm += shx<16>(sm, lane); sm += shx<32>(sm, lane);
    const float mu = sm * (1.f / 96.f);
    float sq = 0.f;
#pragma unroll
    for (int et = 0; et < 6; ++et)
#pragma unroll
        for (int j = 0; j < 4; ++j) { const float dd = o[et][j] - mu; o[et][j] = dd; sq += dd * dd; }
    sq += shx<16>(sq, lane); sq += shx<32>(sq, lane);
    const float rs = rsqrtf(sq * (1.f / 96.f) + EPS);
#pragma unroll
    for (int et = 0; et < 6; ++et) {
        const u32x2 gw = *(const u32x2*)(Z + ZR_OFF + ((size_t)h * TH + tq) * 384 + 288 + et * 16 + fq * 4);
        const float g4[4] = {bf_lo(gw.x), bf_hi(gw.x), bf_lo(gw.y), bf_hi(gw.y)};
        float y[4];
#pragma unroll
        for (int j = 0; j < 4; ++j) { const float gg = g4[j]; y[j] = o[et][j] * rs * (gg * __builtin_amdgcn_rcpf(1.0f + __expf(-gg))); }
        u32x2 w; w.x = cvt_pk_bf16(y[0], y[1]); w.y = cvt_pk_bf16(y[2], y[3]);
#ifdef DBG_ZRET
        w.x = 0u; w.y = 0u;
#endif
        *(u32x2*)(YA + tq * D + 384 + h * 96 + et * 16 + fq * 4) = w;
    }
    __syncthreads();
}

struct MergeLd { float l0, l1, l2; u32x4 a, b, c; };
__device__ __forceinline__ MergeLd merge_load(const bf16_t* PO01, const bf16_t* PO2, const float* LSE, int it) {
    const int tok = it / 48, grp = it % 48, h = grp >> 3; MergeLd m;
    m.l0 = LSE[(size_t)tok * 6 + h]; m.l1 = LSE[(size_t)TH * 6 + (size_t)tok * 6 + h]; m.l2 = LSE[(size_t)2 * TH * 6 + (size_t)tok * 6 + h];
    m.a = *(const u32x4*)(PO01 + (size_t)tok * 384 + grp * 8); m.b = *(const u32x4*)(PO01 + (size_t)TH * 384 + (size_t)tok * 384 + grp * 8); m.c = *(const u32x4*)(PO2 + (size_t)tok * 384 + grp * 8);
    return m;
}
__device__ __forceinline__ void merge_store(const MergeLd& m, bf16_t* YA, int it) {
    const int tok = it / 48, grp = it % 48;
    const float M = fmaxf(m.l0, fmaxf(m.l1, m.l2));
    float w0 = fexp2(m.l0 - M), w1 = fexp2(m.l1 - M), w2 = fexp2(m.l2 - M);
    const float inv = __builtin_amdgcn_rcpf(w0 + w1 + w2); w0 *= inv; w1 *= inv; w2 *= inv;
    const u32x4 a = m.a, b = m.b, c = m.c; u32x4 o;
    o.x = cvt_pk_bf16(w0 * bf_lo(a.x) + w1 * bf_lo(b.x) + w2 * bf_lo(c.x), w0 * bf_hi(a.x) + w1 * bf_hi(b.x) + w2 * bf_hi(c.x));
    o.y = cvt_pk_bf16(w0 * bf_lo(a.y) + w1 * bf_lo(b.y) + w2 * bf_lo(c.y), w0 * bf_hi(a.y) + w1 * bf_hi(b.y) + w2 * bf_hi(c.y));
    o.z = cvt_pk_bf16(w0 * bf_lo(a.z) + w1 * bf_lo(b.z) + w2 * bf_lo(c.z), w0 * bf_hi(a.z) + w1 * bf_hi(b.z) + w2 * bf_hi(c.z));
    o.w = cvt_pk_bf16(w0 * bf_lo(a.w) + w1 * bf_lo(b.w) + w2 * bf_lo(c.w), w0 * bf_hi(a.w) + w1 * bf_hi(b.w) + w2 * bf_hi(c.w));
#ifdef DBG_ZATT
    o = (u32x4){0u, 0u, 0u, 0u};
#endif
    *(u32x4*)(YA + (size_t)tok * D + grp * 8) = o;
}
struct ConvLd { u32x4 bc, cc0, uc0, cc1, uc1, cc2, uc2; };
__device__ __forceinline__ ConvLd conv_load(const bf16_t* Z, int S, int it) {
    const int tok = it >> 5, ch0 = (it & 31) * 8, pos = tok % S; ConvLd v;
    const bf16_t* zr = Z + ZC_OFF + (size_t)tok * 768;
    v.bc = *(const u32x4*)(zr + ch0); v.cc1 = *(const u32x4*)(zr + 256 + ch0); v.uc1 = *(const u32x4*)(zr + 512 + ch0);
    v.cc0 = (u32x4){0u, 0u, 0u, 0u}; v.uc0 = v.cc0; v.cc2 = v.cc0; v.uc2 = v.cc0;
    if (pos > 0) { v.cc0 = *(const u32x4*)(zr - 768 + 256 + ch0); v.uc0 = *(const u32x4*)(zr - 768 + 512 + ch0); }
    if (pos < S - 1) { v.cc2 = *(const u32x4*)(zr + 768 + 256 + ch0); v.uc2 = *(const u32x4*)(zr + 768 + 512 + ch0); }
    return v;
}
__device__ __forceinline__ void conv_store(const ConvLd& v, const float* convw, bf16_t* YA, int it) {
    const int tok = it >> 5, ch0 = (it & 31) * 8;
    const unsigned B[4] = {v.bc.x, v.bc.y, v.bc.z, v.bc.w}, C0[4] = {v.cc0.x, v.cc0.y, v.cc0.z, v.cc0.w}, U0[4] = {v.uc0.x, v.uc0.y, v.uc0.z, v.uc0.w},
                   C1[4] = {v.cc1.x, v.cc1.y, v.cc1.z, v.cc1.w}, U1[4] = {v.uc1.x, v.uc1.y, v.uc1.z, v.uc1.w}, C2[4] = {v.cc2.x, v.cc2.y, v.cc2.z, v.cc2.w}, U2[4] = {v.uc2.x, v.uc2.y, v.uc2.z, v.uc2.w};
    const f32x4 wa0 = *(const f32x4*)(convw + ch0), wa1 = *(const f32x4*)(convw + ch0 + 4), wb0 = *(const f32x4*)(convw + 256 + ch0), wb1 = *(const f32x4*)(convw + 256 + ch0 + 4),
                wc0 = *(const f32x4*)(convw + 512 + ch0), wc1 = *(const f32x4*)(convw + 512 + ch0 + 4);
    const float W0[8] = {wa0.x, wa0.y, wa0.z, wa0.w, wa1.x, wa1.y, wa1.z, wa1.w}, W1[8] = {wb0.x, wb0.y, wb0.z, wb0.w, wb1.x, wb1.y, wb1.z, wb1.w}, W2[8] = {wc0.x, wc0.y, wc0.z, wc0.w, wc1.x, wc1.y, wc1.z, wc1.w};
    unsigned ow[4];
#pragma unroll
    for (int e2 = 0; e2 < 4; ++e2) {
        const float a0 = bf_lo(C0[e2]) * bf_lo(U0[e2]) * W0[2 * e2] + bf_lo(C1[e2]) * bf_lo(U1[e2]) * W1[2 * e2] + bf_lo(C2[e2]) * bf_lo(U2[e2]) * W2[2 * e2];
        const float a1 = bf_hi(C0[e2]) * bf_hi(U0[e2]) * W0[2 * e2 + 1] + bf_hi(C1[e2]) * bf_hi(U1[e2]) * W1[2 * e2 + 1] + bf_hi(C2[e2]) * bf_hi(U2[e2]) * W2[2 * e2 + 1];
        ow[e2] = cvt_pk_bf16(bf_lo(B[e2]) * a0, bf_hi(B[e2]) * a1);
    }
#ifdef DBG_ZCONV
    ow[0] = ow[1] = ow[2] = ow[3] = 0u;
#endif
    *(u32x4*)(YA + (size_t)tok * D + 768 + ch0) = (u32x4){ow[0], ow[1], ow[2], ow[3]};
}
__device__ __forceinline__ void merge_conv(const bf16_t* Z, const bf16_t* PO01, const bf16_t* PO2, const float* LSE, const float* convw, bf16_t* YA, int S, int gtid, int nthr) {
    for (int it = gtid; it < TH * 48; it += 2 * nthr) {
        const int it2 = it + nthr; const bool two = it2 < TH * 48;
        const MergeLd m0 = merge_load(PO01, PO2, LSE, it); MergeLd m1 = m0; if (two) m1 = merge_load(PO01, PO2, LSE, it2);
        merge_store(m0, YA, it); if (two) merge_store(m1, YA, it2);
    }
    for (int it = gtid; it < TH * 32; it += 2 * nthr) {
        const int it2 = it + nthr; const bool two = it2 < TH * 32;
        const ConvLd c0 = conv_load(Z, S, it); ConvLd c1 = c0; if (two) c1 = conv_load(Z, S, it2);
        conv_store(c0, convw, YA, it); if (two) conv_store(c1, convw, YA, it2);
    }
}

#define XB_TMO      128
#define XB_XCNT(j)  (256  + 64 * (j))
#define XB_XSUB(j)  (1280 + 64 * (j))
#define XB_XGEN(j)  (2304 + 64 * (j))
#define XB_TOP      3328
#define XB_TOPGEN   3392
#define XCD_BAR_WORDS 3456
#define XB_SPIN_CAP (1u << 22)
__device__ __forceinline__ unsigned xb_ld(unsigned* p)              { return __hip_atomic_load(p, __ATOMIC_RELAXED, __HIP_MEMORY_SCOPE_AGENT); }
__device__ __forceinline__ unsigned xb_add(unsigned* p, unsigned v) { return __hip_atomic_fetch_add(p, v, __ATOMIC_RELAXED, __HIP_MEMORY_SCOPE_AGENT); }
__device__ __forceinline__ unsigned xb_xcc_id() { return (unsigned)__builtin_amdgcn_s_getreg((3 << 11) | 20) & 0xFu; }
#define XB_SPIN(cond, bar) do { unsigned _sp = 0; while (cond) { __builtin_amdgcn_s_sleep(16); \
    if ((++_sp & 255u) == 0u) { if (xb_ld(&(bar)[XB_TMO])) break; if (_sp > XB_SPIN_CAP) { atomicAdd(&(bar)[XB_TMO], 1u); break; } } } } while (0)
struct XcdBarrier { unsigned* bar; unsigned x; volatile LAS unsigned* st; };
__device__ __forceinline__ XcdBarrier xcd_barrier_post(unsigned* bar, volatile LAS unsigned* st) {
    XcdBarrier b; b.bar = bar; b.x = xb_xcc_id(); b.st = st;
    if (threadIdx.x == 0) (void)xb_add(&bar[XB_XCNT(b.x)], 1u);
    return b;
}
__device__ __forceinline__ void xcd_barrier_complete(unsigned* bar, unsigned x, unsigned& nloc, unsigned& nx) {
    const unsigned G = gridDim.x * gridDim.y * gridDim.z;
    unsigned sum, cnt, mine, sp = 0u;
    for (;;) {
        sum = 0u; cnt = 0u; mine = 0u;
#pragma unroll
        for (unsigned j = 0; j < 16; ++j) { const unsigned c = xb_ld(&bar[XB_XCNT(j)]); sum += c; cnt += (c > 0u) ? 1u : 0u; mine = (j == x) ? c : mine; }
        if (sum == G) break;
        __builtin_amdgcn_s_sleep(1);
        if ((++sp & 255u) == 0u) { if (xb_ld(&bar[XB_TMO])) break; if (sp > XB_SPIN_CAP) { atomicAdd(&bar[XB_TMO], 1u); break; } }
    }
    nloc = mine > 0u ? mine : 1u; nx = cnt > 0u ? cnt : 1u;
}
__device__ __forceinline__ void xcd_barrier(const XcdBarrier& b) {
    asm volatile("s_waitcnt vmcnt(0)" ::: "memory");
    __syncthreads();
    if (threadIdx.x == 0) {
        unsigned* bar = b.bar; asm volatile("" : "+s"(bar));
        unsigned bxx = b.x; asm volatile("" : "+s"(bxx));
        __builtin_amdgcn_s_waitcnt(0);
        unsigned nloc = b.st[0], nx = b.st[1];
        if (nloc == 0u) { xcd_barrier_complete(bar, bxx, nloc, nx); b.st[0] = nloc; b.st[1] = nx; }
        const unsigned old = xb_add(&bar[XB_XSUB(bxx)], 1u);
        const unsigned gen = old / nloc;
        if (old + 1u == (gen + 1u) * nloc) {
            __builtin_amdgcn_fence(__ATOMIC_RELEASE, "agent");
            asm volatile("s_waitcnt vmcnt(0)" ::: "memory");
            const unsigned og = xb_add(&bar[XB_TOP], 1u);
            const unsigned tg = og / nx;
            if (og + 1u == (tg + 1u) * nx) xb_add(&bar[XB_TOPGEN], 1u);
            else XB_SPIN(xb_ld(&bar[XB_TOPGEN]) == tg, bar);
            __builtin_amdgcn_fence(__ATOMIC_ACQUIRE, "agent");
            xb_add(&bar[XB_XGEN(bxx)], 1u);
            asm volatile("s_waitcnt vmcnt(0)" ::: "memory");
        } else {
            XB_SPIN(xb_ld(&bar[XB_XGEN(bxx)]) == gen, bar);
            __builtin_amdgcn_fence(__ATOMIC_ACQUIRE, "agent");
            asm volatile("s_waitcnt vmcnt(0)" ::: "memory");
        }
    }
    __syncthreads();
}

__global__ void __launch_bounds__(512, 2) mega_fwd(Params P) {
    extern __shared__ __attribute__((aligned(16))) unsigned char lds_raw[];
    cg::grid_group grid = cg::this_grid();
    LAS unsigned char* lds = (LAS unsigned char*)lds_raw;
    const int tid0 = threadIdx.x, wave0 = __builtin_amdgcn_readfirstlane(tid0 >> 6);
    const int G = gridDim.x, bx0 = blockIdx.x;
    const int ngw = G * 8, nthr = G * 512;
    int wave = wave0, bx = bx0, gw = bx0 * 8 + wave0;
    unsigned char* ws0 = P.ws;
    unsigned char* ws = ws0;

    if (tid0 < 64) ((LAS unsigned*)(lds + LDS_STAGE))[tid0] = 0u;
    if (bx0 == 0) for (int wI = tid0; wI < 4096; wI += 512) __hip_atomic_store((unsigned*)(ws + WS_BAR) + wI, 0u, __ATOMIC_RELAXED, __HIP_MEMORY_SCOPE_AGENT);
    asm volatile("s_waitcnt vmcnt(0)" ::: "memory");
    __syncthreads();
    grid.sync();
    const XcdBarrier xbar = xcd_barrier_post((unsigned*)(ws + WS_BAR), (volatile LAS unsigned*)(lds + LDS_STAGE));
    for (int rep = 0; rep < NREP(5); ++rep) { __syncthreads(); phase_weights(P, lds, gw, ngw, wave, tid0 & 63, bx * 512 + tid0, nthr); }
    row_pass(nullptr, P.in[0], (bf16_t*)P.out + 1024, (float*)(ws + WS_RS), nullptr, nullptr, 0.f, TH, gw, ngw, tid0 & 63);
    xcd_barrier(xbar);

#if REP_MASK
    for (int st = 0; st < 100; ++st) {
      const int ph = st >> 1, rep = st & 1;
      if (rep) { const int q_ = ph % 25; int kind = 15;
          if (q_ == 0) kind = 6; else { const int r_ = (q_ - 1) % 12;
              kind = (r_ == 0 || r_ == 9) ? 0 : (r_ == 1 || r_ == 3 || r_ == 7 || r_ == 10) ? 1 : (r_ == 4) ? 2 : (r_ == 6) ? 3 : ((r_ == 2 || r_ == 8 || r_ == 11) && !(r_ == 11 && q_ > 12)) ? 4 : 15; }
          if (!((REP_MASK >> kind) & 1)) continue; }
      {
#else
    for (int ph = 0; ph < 50; ++ph) {
      const int rep = 0;
      {
#endif
        int wv = wave0; asm volatile("" : "+s"(wv));
        unsigned allm = ~0u; asm volatile("" : "+s"(allm));
        int tid = wv * 64 + (int)__builtin_amdgcn_mbcnt_hi(allm, __builtin_amdgcn_mbcnt_lo(allm, 0u)); asm volatile("" : "+v"(tid));
        unsigned char* ws = ws0; asm volatile("" : "+s"(ws));
        bf16_t* WB = (bf16_t*)(ws + WS_W);
        bf16_t* XA = (bf16_t*)(ws + WS_XA);
        bf16_t* OB = (bf16_t*)(ws + WS_OB);
        bf16_t* BIG = (bf16_t*)(ws + WS_BIG);
        bf16_t* ST = (bf16_t*)(ws + WS_ST);
        bf16_t* PO2 = (bf16_t*)(ws + WS_P2);
        float* LSE = (float*)(ws + WS_OB + OB_LSE_OFF);
        float* RS = (float*)(ws + WS_RS);
        const float* gains = P.in[2];
        int bx = bx0; asm volatile("" : "+s"(bx));
        const int wave = __builtin_amdgcn_readfirstlane(tid >> 6), gw = bx * 8 + wave;
        const int lane = tid & 63, gtid = bx * 512 + tid;
        const int hf = ph / 25, q = ph % 25;
        const int S = hf ? 4096 : 2048;
        const float* xin = P.in[hf];
        float* xout = P.out + (size_t)hf * TH * D;
        bf16_t* X16 = (bf16_t*)xout + 1024;
        if (q == 0) continue;
        {
            const int l = (q - 1) / 12, r = (q - 1) % 12;
            const bf16_t* wl = WB + (size_t)l * L_ELEMS;
            const float* gl = gains + (size_t)l * 6 * D;
            if (r == 0 || r == 9) {
                pg8::Gemm g{X16, wl + (r == 0 ? L_UP1 : L_UP2), TH, NUP, D, XP}; pg8::StaticOrder So; So.init(TH, NUP, G, bx);
                pg8::EpiSwiglu E{BIG, FF};
                pg8::gemm_phase<pg8::EpiSwiglu, true>(lds, g, So, E, tid);
            } else if (r == 1 || r == 3 || r == 7 || r == 10) {
                pg8::Gemm g; pg8::EpiStore E;
                if (r == 1 || r == 10) { g = pg8::Gemm{BIG, wl + (r == 1 ? L_DN1 : L_DN2), TH, D, FF, FF}; E = pg8::EpiStore{OB, D, D, nullptr}; }
                else if (r == 3) { g = pg8::Gemm{X16, wl + L_IN, TH, NINP, D, XP}; E = pg8::EpiStore{BIG, 0, NIN, nullptr}; }
                else { g = pg8::Gemm{XA, wl + L_OUT, TH, D, D, D}; E = pg8::EpiStore{OB, D, D, nullptr}; }
                pg8::StaticOrder So; So.init(TH, g.N, G, bx);
                pg8::gemm_phase<pg8::EpiStore, true>(lds, g, So, E, tid);
            } else if (r == 2 || r == 8 || r == 11) {
                const float* gpost = gl + (r == 2 ? 1 : r == 8 ? 3 : 5) * D;
                const bool fin = (r == 11 && l + 1 == DEPTH);
                row_pass(OB, (l == 0 && r == 2 && rep == 0) ? xin : nullptr, X16, RS, fin ? xout : nullptr, gpost, rep ? 0.0f : ((r == 8) ? 1.0f : 0.5f), TH, gw, ngw, lane);
                if (fin && hf == 0) row_pass(nullptr, P.in[1], (bf16_t*)(P.out + (size_t)TH * D) + 1024, RS, nullptr, nullptr, 0.f, TH, gw, ngw, lane);
            } else {
                volatile LAS float* lgs = (volatile LAS float*)(lds + LDS_STAGE + 128);
                if (tid < 8) lgs[tid] = -__log2f(1.0f + __expf(-(P.in[8] + l * 8)[tid]));
                __syncthreads();
                if (r == 4) {
                    { AttnStage ast = attn_load(BIG, S, bx % 4608, tid, wave, lane);
                      for (int it = bx; it < 4608; it += G) {
                        const int p = it / 1536, itn = (it + G < 4608) ? it + G : it;
                        ast = attn_item(lds, BIG, (p < 2) ? OB + (size_t)p * TH * 384 : PO2, LSE + (size_t)p * TH * 6, S, it, itn, ast, tid, wave, lane);
                      } }
                    for (int it = bx; it < 1024; it += G) {
                        const int h = it & 3;
                        const float lgf2 = lgs[h], lgb2 = lgs[4 + h];
                        retkv_item(lds, BIG, ST, it, lgf2, lgb2, tid, wave, lane);
                    }
                } else if (r == 5) {
                    ret_scan(ST, S, lgs, gtid, nthr);
                    __syncthreads();
                } else {
                    for (int it = bx; it < 1024; it += G) {
                        const int h = it & 3;
                        const float lgf2 = lgs[h], lgb2 = lgs[4 + h];
                        retout_item(lds, BIG, ST, XA, it, lgf2, lgb2, tid, wave, lane);
                    }
                    merge_conv(BIG, OB, PO2, LSE, P.in[7] + l * 768, XA, S, gtid, nthr);
                }
            }
        }
      }
        for (int rp = 0; rp < NREP(7); ++rp) xcd_barrier(xbar);
    }
}

extern "C" void kernel_launch(void* const* d_in, const int* in_sizes, int n_in, void* d_out, int out_size, void* d_ws, size_t ws_size, hipStream_t stream) {
    static int grid = 0;
    if (grid == 0) {
        if (n_in != 13 || ws_size < WS_TOTAL) { fprintf(stderr, "kernel_launch: need 13 inputs and >= %zu bytes of workspace (got %d, %zu)\n", (size_t)WS_TOTAL, n_in, ws_size); grid = -1; return; }
        int dev = 0, cus = 0, per_cu = 0;
        hipGetDevice(&dev);
        hipDeviceGetAttribute(&cus, hipDeviceAttributeMultiprocessorCount, dev);
        hipFuncSetAttribute((const void*)mega_fwd, hipFuncAttributeMaxDynamicSharedMemorySize, LDS_BYTES);
        hipOccupancyMaxActiveBlocksPerMultiprocessor(&per_cu, (const void*)mega_fwd, 512, LDS_BYTES);
        if (per_cu < 1) per_cu = 1;
        grid = cus * per_cu;
        fprintf(stderr, "kernel_launch: grid %d (cus %d x %d)\n", grid, cus, per_cu);
    }
    if (grid < 0) return;
    Params p{};
    for (int i = 0; i < 13; ++i) p.in[i] = (const float*)d_in[i];
    p.out = (float*)d_out; p.ws = (unsigned char*)d_ws;
    void* args[] = {&p};
    hipError_t e = hipLaunchCooperativeKernel((const void*)mega_fwd, dim3(grid), dim3(512), args, LDS_BYTES, stream);
    if (e != hipSuccess) fprintf(stderr, "cooperative launch failed: %s (grid %d)\n", hipGetErrorString(e), grid);
}
```

```cpp
#ifndef REP_MASK
#define REP_MASK 0
#endif
#define NREP(k) ((((REP_MASK) >> (k)) & 1) + 1)
#include <hip/hip_runtime.h>
#include <hip/hip_cooperative_groups.h>
#include <cstdio>
#include <cstdint>
namespace cg = cooperative_groups;

#define LAS __attribute__((address_space(3)))
typedef unsigned short bf16_t;
typedef short bf16x8 __attribute__((ext_vector_type(8)));
typedef short bf16x4 __attribute__((ext_vector_type(4)));
typedef float f32x4 __attribute__((ext_vector_type(4)));
typedef unsigned u32x4 __attribute__((ext_vector_type(4)));
typedef unsigned u32x2 __attribute__((ext_vector_type(2)));

constexpr int D = 1024, FF = 2816, NUP = 5632, NIN = 3456, NINP = 3584, TH = 32768, ZS = 3456, DEPTH = 2;
constexpr float EPS = 1e-6f;
constexpr float LOG2E = 1.4426950408889634f;
constexpr size_t ZA_OFF = 0, ZR_OFF = (size_t)TH * 1152, ZC_OFF = (size_t)TH * 2688;
constexpr size_t L_UP1 = 0, L_DN1 = 5767168, L_IN = 8650752, L_OUT = 12320768, L_UP2 = 13369344, L_DN2 = 19136512, L_ELEMS = 22020096;
constexpr size_t WS_W = 0, WS_XA = 2 * L_ELEMS * 2, WS_OB = WS_XA + (size_t)TH * D * 2, WS_BIG = WS_OB + (size_t)TH * D * 2,
                 WS_ST = WS_BIG + (size_t)TH * ZS * 2, WS_P2 = WS_ST + (size_t)256 * 4 * 2 * 9216 * 2, WS_END = WS_P2 + (size_t)TH * 384 * 2;
constexpr size_t WS_BAR = WS_END, WS_RS = WS_BAR + 16384, WS_TOTAL = WS_RS + (size_t)TH * 4;
constexpr size_t OB_LSE_OFF = (size_t)2 * TH * 384 * 2;
constexpr int LDS_STAGE = 131072, LDS_BYTES = LDS_STAGE + 256;

__device__ __forceinline__ unsigned cvt_pk_bf16(float lo, float hi) { unsigned r; asm volatile("v_cvt_pk_bf16_f32 %0, %1, %2" : "=v"(r) : "v"(lo), "v"(hi)); return r; }
__device__ __forceinline__ float bf_lo(unsigned w) { return __uint_as_float(w << 16); }
__device__ __forceinline__ float bf_hi(unsigned w) { return __uint_as_float(w & 0xffff0000u); }
__device__ __forceinline__ float wave_sum(float v) {
#pragma unroll
    for (int o = 1; o < 64; o <<= 1) v += __shfl_xor(v, o);
    return v;
}
__device__ __forceinline__ float fexp2(float x) { return __builtin_amdgcn_exp2f(x); }
template <int O> __device__ __forceinline__ float shx(float v, int lane) {
    if constexpr (O < 32) return __int_as_float(__builtin_amdgcn_ds_swizzle(__float_as_int(v), 0x1f | (O << 10)));
    else return __int_as_float(__builtin_amdgcn_ds_bpermute((lane ^ 32) << 2, __float_as_int(v)));
}
__device__ __forceinline__ float shx(float v, int o, int lane) { return __int_as_float(__builtin_amdgcn_ds_bpermute((lane ^ o) << 2, __float_as_int(v))); }

namespace pg8 {
constexpr int BM = 256, BK = 64, HALF = 128, HTB = HALF * BK * 2, STAGE_BYTES = 8 * HTB, NXCD = 8, WGM = 8;
__host__ __device__ __forceinline__ int lds_byte(int r, int c) { const int st = (r >> 4) * 2 + (c >> 5), rr = r & 15, cc = c & 31, ob = rr * 64 + cc * 2; return st * 1024 + (ob ^ (((ob >> 9) & 1) << 5)); }
__host__ __device__ __forceinline__ void stage_rc(int b, int& R, int& C) { const int st = b / 1024, sb = b % 1024, swz = sb ^ (((sb >> 9) & 1) << 5); R = (st >> 1) * 16 + swz / 64; C = (st & 1) * 32 + (swz % 64) / 2; }
__host__ __device__ __forceinline__ int perm32(int rho) { const int n = rho >> 4, i = rho & 15; return 8 * (i >> 2) + 4 * n + (i & 3); }

struct Unit { int pm, pn; };
struct Gemm { const bf16_t* A; const bf16_t* Bt; int M, N, K, lda; };

struct StaticOrder {
    int nM, nN, nwg, G, c; bool revn;
    __device__ void init(int M, int N, int G_, int c_, bool revn_ = false) { nM = M / BM; nN = N / BM; nwg = nM * nN; G = G_; c = c_; revn = revn_; }
    __device__ bool next(int i, Unit& u) const {
        const long L = (long)i * G + c; if (L >= nwg) return false;
        int wgid = (int)L; { const int q = nwg / NXCD, r = nwg % NXCD, xcd = wgid % NXCD, off = wgid / NXCD; wgid = (xcd < r ? xcd * (q + 1) : r * (q + 1) + (xcd - r) * q) + off; }
        const int nig = WGM * nN, gid = wgid / nig, fm = gid * WGM, gsz = (nM - fm) < WGM ? (nM - fm) : WGM;
        u.pm = fm + ((wgid % nig) % gsz); u.pn = (wgid % nig) / gsz; if (revn) u.pn = nN - 1 - u.pn; return true;
    }
};

struct EpiSwiglu {
    static constexpr bool PERM = true;
    bf16_t* H; int ldh;
    __device__ __forceinline__ void operator()(const f32x4 (&acc)[2][2][4][2], const Unit& u, int wr, int wc, int fr, int fq) const {
        const int row0 = u.pm * BM + wr * 64 + fr, col0 = u.pn * HALF + wc * 32 + 8 * fq;
#pragma unroll
        for (int ai = 0; ai < 2; ++ai)
#pragma unroll
            for (int m = 0; m < 4; ++m) {
                bf16_t* p = H + (size_t)(row0 + ai * HALF + m * 16) * ldh + col0;
                float v[8];
#pragma unroll
                for (int n = 0; n < 2; ++n)
#pragma unroll
                    for (int j = 0; j < 4; ++j) { const float g = acc[ai][0][m][n][j], up = acc[ai][1][m][n][j];
                        v[n * 4 + j] = g * __builtin_amdgcn_rcpf(1.0f + __expf(-g)) * up; }
                u32x4 w; w.x = cvt_pk_bf16(v[0], v[1]); w.y = cvt_pk_bf16(v[2], v[3]); w.z = cvt_pk_bf16(v[4], v[5]); w.w = cvt_pk_bf16(v[6], v[7]);
                *(u32x4*)p = w;
            }
    }
};
struct EpiStore {
    static constexpr bool PERM = true;
    bf16_t* O; int ldc; int ncols; const float* rs;
    __device__ __forceinline__ void operator()(const f32x4 (&acc)[2][2][4][2], const Unit& u, int wr, int wc, int fr, int fq) const {
        const int row0 = u.pm * BM + wr * 64 + fr, col0 = u.pn * BM + wc * 32 + 8 * fq;
        unsigned base[2];
#pragma unroll
        for (int bj = 0; bj < 2; ++bj) { const int c = col0 + bj * HALF;
            if (ldc) { base[bj] = (unsigned)c; }
            else if (c < 1152) { const int w3 = c / 384, rm = c % 384, h = rm >> 6, e = rm & 63; base[bj] = (unsigned)(ZA_OFF + (size_t)h * TH * 192 + w3 * 64 + e) | 1u; }
            else if (c < 2688) { const int cc = c - 1152, w4 = cc / 384, rm = cc % 384, h = rm / 96, e = rm % 96; base[bj] = (unsigned)(ZR_OFF + (size_t)h * TH * 384 + w4 * 96 + e) | 2u; }
            else { base[bj] = (unsigned)(ZC_OFF + (size_t)(c - 2688)) | 3u; } }
#pragma unroll
        for (int ai = 0; ai < 2; ++ai)
#pragma unroll
            for (int m = 0; m < 4; ++m) {
                const unsigned row = (unsigned)(row0 + ai * HALF + m * 16);
#pragma unroll
                for (int bj = 0; bj < 2; ++bj) {
                    const f32x4 v0 = acc[ai][bj][m][0], v1 = acc[ai][bj][m][1];
                    u32x4 w; w.x = cvt_pk_bf16(v0[0], v0[1]); w.y = cvt_pk_bf16(v0[2], v0[3]); w.z = cvt_pk_bf16(v1[0], v1[1]); w.w = cvt_pk_bf16(v1[2], v1[3]);
                    const unsigned code = base[bj] & 3u, pitch = code ? (96u << code) : (unsigned)ldc;
                    if (col0 + bj * HALF < ncols) *(u32x4*)(O + (size_t)((base[bj] & ~3u) + row * pitch)) = w;
                }
            }
    }
};

template <class Epi, bool ALIGN_EPI, bool SP2 = true>
__device__ __forceinline__ void gemm_phase(LAS unsigned char* lds, const Gemm g, const StaticOrder& S, const Epi& E, const int tid) {
    const int wid = __builtin_amdgcn_readfirstlane(tid >> 6), lane = tid & 63, wr = wid >> 2, wc = wid & 3, fr = lane & 15, fq = lane >> 4;
    const int K = g.K, nt = K / BK;
    unsigned voffA[2], voffB[2];
#pragma unroll
    for (int i = 0; i < 2; ++i) { int R, C; stage_rc(tid * 16 + i * 8192, R, C); const int Rb = Epi::PERM ? ((R & ~31) + perm32(R & 31)) : R;
        voffA[i] = (unsigned)(R * g.lda + C) * 2u; voffB[i] = (unsigned)(Rb * K + C) * 2u; }
    const size_t kstep = (size_t)(BK * 2);
    const size_t hstep = (size_t)HALF * K * 2;
    const size_t tstep = 2 * hstep;
    const size_t hstepA = (size_t)HALF * g.lda * 2, tstepA = 2 * hstepA;
    const unsigned ldsw = (unsigned)wid * 1024u;
    const int aoff = lds_byte(wr * 64 + fr, fq * 8), boff = lds_byte(wc * 32 + fr, fq * 8);
#define PG8_SA(b, h) (((b) * 2 + (h)) * HTB)
#define PG8_SB(b, h) ((4 + (b) * 2 + (h)) * HTB)
#define PG8_STAGE(bufoff, gbase, voff) do { _Pragma("unroll") for (int _i = 0; _i < 2; ++_i) \
        __builtin_amdgcn_global_load_lds((const unsigned*)((const char*)(gbase) + (voff)[_i]), (LAS unsigned*)(lds + (bufoff) + ldsw + _i * 8192), 16, 0, 0); } while (0)
#define PG8_LDA(dst, b, h) do { _Pragma("unroll") for (int m = 0; m < 4; ++m) _Pragma("unroll") for (int k = 0; k < 2; ++k) dst[m][k] = *(const LAS bf16x8*)(lds + PG8_SA(b, h) + aoff + m * 2048 + k * 1024); } while (0)
#define PG8_LDB(dst, b, h) do { _Pragma("unroll") for (int n = 0; n < 2; ++n) _Pragma("unroll") for (int k = 0; k < 2; ++k) dst[n][k] = *(const LAS bf16x8*)(lds + PG8_SB(b, h) + boff + n * 2048 + k * 1024); } while (0)
#define PG8_MMA(ai, bj, At, Bt) do { __builtin_amdgcn_s_setprio(1); _Pragma("unroll") for (int m = 0; m < 4; ++m) _Pragma("unroll") for (int n = 0; n < 2; ++n) _Pragma("unroll") for (int k = 0; k < 2; ++k) \
        acc[ai][bj][m][n] = __builtin_amdgcn_mfma_f32_16x16x32_bf16(Bt[n][k], At[m][k], acc[ai][bj][m][n], 0, 0, 0); __builtin_amdgcn_s_setprio(0); } while (0)
#define PG8_WAIT_V(n) asm volatile("s_waitcnt vmcnt(" #n ")" ::: "memory")
#define PG8_WAIT_L(n) asm volatile("s_waitcnt lgkmcnt(" #n ")" ::: "memory")
#define PG8_BAR __builtin_amdgcn_s_barrier()
#define PG8_SCHED __builtin_amdgcn_sched_barrier(0)
    Unit cur, nxt; int ui = 0;
    if (!S.next(0, cur)) return;
    f32x4 acc[2][2][4][2];
#pragma unroll
    for (int a = 0; a < 2; ++a)
#pragma unroll
        for (int b = 0; b < 2; ++b)
#pragma unroll
            for (int m = 0; m < 4; ++m)
#pragma unroll
                for (int n = 0; n < 2; ++n) acc[a][b][m][n] = (f32x4){0.f, 0.f, 0.f, 0.f};
    bf16x8 At[4][2], B0[2][2], B1[2][2];
    const char* cA = (const char*)g.A + (size_t)cur.pm * tstepA; const char* cB = (const char*)g.Bt + (size_t)cur.pn * tstep;
    if constexpr (SP2) {
    PG8_STAGE(PG8_SB(0, 0), cB, voffB); PG8_STAGE(PG8_SB(0, 1), cB + hstep, voffB); PG8_STAGE(PG8_SA(0, 0), cA, voffA); PG8_STAGE(PG8_SA(0, 1), cA + hstepA, voffA);
    if (wr == 1) PG8_BAR;
    PG8_WAIT_V(2); PG8_BAR;
    PG8_STAGE(PG8_SB(1, 0), cB + kstep, voffB); PG8_STAGE(PG8_SA(1, 0), cA + kstep, voffA); PG8_STAGE(PG8_SB(1, 1), cB + hstep + kstep, voffB);
    PG8_WAIT_V(6); PG8_BAR;
    } else {
    PG8_STAGE(PG8_SB(0, 0), cB, voffB); PG8_STAGE(PG8_SA(0, 0), cA, voffA); PG8_STAGE(PG8_SB(0, 1), cB + hstep, voffB); PG8_STAGE(PG8_SA(0, 1), cA + hstepA, voffA);
    if (wr == 1) PG8_BAR;
    PG8_WAIT_V(4); PG8_BAR;
    PG8_STAGE(PG8_SB(1, 0), cB + kstep, voffB); PG8_STAGE(PG8_SA(1, 0), cA + kstep, voffA); PG8_STAGE(PG8_SB(1, 1), cB + hstep + kstep, voffB);
    PG8_WAIT_V(6); PG8_BAR;
    }
    for (;;) {
        const bool has_next = S.next(ui + 1, nxt);
        const char* nA = has_next ? (const char*)g.A + (size_t)nxt.pm * tstepA : cA; const char* nB = has_next ? (const char*)g.Bt + (size_t)nxt.pn * tstep : cB;
        for (int t = 0; t < nt; t += 2) {
            const bool last = (t == nt - 2);
            const char* a1 = cA + (size_t)(t + 1) * kstep;
            const char* a2 = last ? nA : cA + (size_t)(t + 2) * kstep; const char* b2 = last ? nB : cB + (size_t)(t + 2) * kstep;
            const char* a3 = a2 + kstep; const char* b3 = b2 + kstep;
            if constexpr (!SP2) {
            PG8_LDB(B0, 0, 0); PG8_SCHED; PG8_LDA(At, 0, 0); PG8_STAGE(PG8_SA(1, 1), a1 + hstepA, voffA);
            PG8_WAIT_L(8); PG8_BAR; PG8_WAIT_L(0); PG8_MMA(0, 0, At, B0); PG8_BAR; PG8_SCHED;
            PG8_LDB(B1, 0, 1); PG8_STAGE(PG8_SB(0, 0), b2, voffB);
            PG8_BAR; PG8_WAIT_L(0); PG8_MMA(0, 1, At, B1); PG8_BAR;
            PG8_LDA(At, 0, 1); PG8_STAGE(PG8_SA(0, 0), a2, voffA);
            PG8_BAR; PG8_WAIT_L(0); PG8_MMA(1, 0, At, B0); PG8_BAR; PG8_SCHED;
            PG8_STAGE(PG8_SB(0, 1), b2 + hstep, voffB);
            PG8_WAIT_V(6); PG8_BAR; PG8_MMA(1, 1, At, B1); PG8_BAR;
            PG8_LDB(B0, 1, 0); PG8_SCHED; PG8_LDA(At, 1, 0); PG8_STAGE(PG8_SA(0, 1), a2 + hstepA, voffA);
            PG8_WAIT_L(8); PG8_BAR; PG8_WAIT_L(0); PG8_MMA(0, 0, At, B0); PG8_BAR; PG8_SCHED;
            PG8_LDB(B1, 1, 1); PG8_STAGE(PG8_SB(1, 0), b3, voffB);
            PG8_BAR; PG8_WAIT_L(0); PG8_MMA(0, 1, At, B1); PG8_BAR;
            PG8_LDA(At, 1, 1); PG8_STAGE(PG8_SA(1, 0), a3, voffA);
            PG8_BAR; PG8_WAIT_L(0); PG8_MMA(1, 0, At, B0); PG8_BAR; PG8_SCHED;
            PG8_STAGE(PG8_SB(1, 1), b3 + hstep, voffB);
            PG8_WAIT_V(6); PG8_BAR; PG8_MMA(1, 1, At, B1); PG8_BAR;
            } else {
            PG8_LDB(B0, 0, 0); PG8_LDB(B1, 0, 1); PG8_SCHED; PG8_LDA(At, 0, 0); PG8_STAGE(PG8_SA(1, 1), a1 + hstepA, voffA);
            PG8_WAIT_V(8); PG8_WAIT_L(0); PG8_BAR; PG8_MMA(0, 0, At, B0); PG8_MMA(0, 1, At, B1); PG8_BAR; PG8_SCHED;
            PG8_LDA(At, 0, 1); PG8_STAGE(PG8_SB(0, 0), b2, voffB); PG8_STAGE(PG8_SB(0, 1), b2 + hstep, voffB); PG8_STAGE(PG8_SA(0, 0), a2, voffA);
            PG8_WAIT_V(8); PG8_WAIT_L(0); PG8_BAR; PG8_MMA(1, 0, At, B0); PG8_MMA(1, 1, At, B1); PG8_BAR; PG8_SCHED;
            PG8_LDB(B0, 1, 0); PG8_LDB(B1, 1, 1); PG8_SCHED; PG8_LDA(At, 1, 0); PG8_STAGE(PG8_SA(0, 1), a2 + hstepA, voffA);
            PG8_WAIT_V(8); PG8_WAIT_L(0); PG8_BAR; PG8_MMA(0, 0, At, B0); PG8_MMA(0, 1, At, B1); PG8_BAR; PG8_SCHED;
            PG8_LDA(At, 1, 1); PG8_STAGE(PG8_SB(1, 0), b3, voffB); PG8_STAGE(PG8_SB(1, 1), b3 + hstep, voffB); PG8_STAGE(PG8_SA(1, 0), a3, voffA);
            PG8_WAIT_V(8); PG8_WAIT_L(0); PG8_BAR; PG8_MMA(1, 0, At, B0); PG8_MMA(1, 1, At, B1); PG8_BAR; PG8_SCHED;
            }
        }
        if constexpr (ALIGN_EPI) { if (wr == 0) PG8_BAR; }
        E(acc, cur, wr, wc, fr, fq);
        if (!has_next) break;
#pragma unroll
        for (int a = 0; a < 2; ++a)
#pragma unroll
            for (int b = 0; b < 2; ++b)
#pragma unroll
                for (int m = 0; m < 4; ++m)
#pragma unroll
                    for (int n = 0; n < 2; ++n) acc[a][b][m][n] = (f32x4){0.f, 0.f, 0.f, 0.f};
        cur = nxt; cA = nA; cB = nB; ++ui;
        if constexpr (ALIGN_EPI) { if (wr == 1) PG8_BAR; }
    }
    PG8_WAIT_V(0);
    if constexpr (!ALIGN_EPI) { if (wr == 0) PG8_BAR; }
    PG8_BAR;
#undef PG8_SA
#undef PG8_SB
#undef PG8_STAGE
#undef PG8_LDA
#undef PG8_LDB
#undef PG8_MMA
#undef PG8_WAIT_V
#undef PG8_WAIT_L
#undef PG8_BAR
#undef PG8_SCHED
}
}

struct Params { const float* in[13]; float* out; unsigned char* ws; };

__device__ __forceinline__ void transpose_item(const float* W, int K, int N, bf16_t* WT, int mode, LAS float* scr, int item, int lane, const float* gk) {
    const int nblk = N / 32, kb = item / nblk, nb = item % nblk, k0 = 64 * kb, n0 = 32 * nb;
    const int r0 = (mode == 0) ? n0 : ((n0 >> 7) * 256 + (n0 & 127) + (mode == 2 ? 128 : 0));
    f32x4 wv[8];
#pragma unroll
    for (int i = 0; i < 8; ++i) { const int kk = 8 * i + (lane >> 3); wv[i] = *(const f32x4*)(W + (size_t)(k0 + kk) * N + n0 + 4 * (lane & 7)); }
#pragma unroll
    for (int i = 0; i < 8; ++i) { const int kk = 8 * i + (lane >> 3); const float gg = gk ? gk[k0 + kk] : 1.0f; LAS float* d = scr + kk * 33 + 4 * (lane & 7);
        d[0] = wv[i].x * gg; d[1] = wv[i].y * gg; d[2] = wv[i].z * gg; d[3] = wv[i].w * gg; }
    asm volatile("s_waitcnt lgkmcnt(0)" ::: "memory");
    const int c = lane & 7;
#pragma unroll
    for (int j = 0; j < 4; ++j) { const int n = (lane >> 3) + 8 * j; const LAS float* s = scr + (8 * c) * 33 + n;
        u32x4 o; o.x = cvt_pk_bf16(s[0 * 33], s[1 * 33]); o.y = cvt_pk_bf16(s[2 * 33], s[3 * 33]); o.z = cvt_pk_bf16(s[4 * 33], s[5 * 33]); o.w = cvt_pk_bf16(s[6 * 33], s[7 * 33]);
        *(u32x4*)(WT + (size_t)(r0 + n) * K + k0 + 8 * c) = o; }
    asm volatile("s_waitcnt lgkmcnt(0)" ::: "memory");
}

__device__ __forceinline__ void phase_weights(const Params& P, LAS unsigned char* lds, int gw, int ngw, int wave, int lane, int gtid, int nthr) {
    LAS float* scr = (LAS float*)(lds + wave * 8448);
    bf16_t* WB = (bf16_t*)(P.ws + WS_W);
    constexpr int I_G = 16 * 88, I_D = 44 * 32, I_I = 16 * 108, I_O = 16 * 32;
    constexpr int PER_LAYER = 6 * I_G + I_I + I_O;
    static_assert(I_G == I_D, "");
    for (int it = gw; it < DEPTH * PER_LAYER; it += ngw) {
        const int l = it / PER_LAYER; int r = it % PER_LAYER;
        bf16_t* wl = WB + (size_t)l * L_ELEMS; const float* gl = P.in[2] + (size_t)l * 6 * D;
        if (r < I_G) { transpose_item(P.in[3] + (size_t)l * D * FF, D, FF, wl + L_UP1, 1, scr, r, lane, gl); continue; } r -= I_G;
        if (r < I_G) { transpose_item(P.in[4] + (size_t)l * D * FF, D, FF, wl + L_UP1, 2, scr, r, lane, gl); continue; } r -= I_G;
        if (r < I_D) { transpose_item(P.in[5] + (size_t)l * D * FF, FF, D, wl + L_DN1, 0, scr, r, lane, nullptr); continue; } r -= I_D;
        if (r < I_I) { transpose_item(P.in[6] + (size_t)l * D * NIN, D, NIN, wl + L_IN, 0, scr, r, lane, gl + 2 * D); continue; } r -= I_I;
        if (r < I_O) { transpose_item(P.in[9] + (size_t)l * D * D, D, D, wl + L_OUT, 0, scr, r, lane, nullptr); continue; } r -= I_O;
        if (r < I_G) { transpose_item(P.in[10] + (size_t)l * D * FF, D, FF, wl + L_UP2, 1, scr, r, lane, gl + 4 * D); continue; } r -= I_G;
        if (r < I_G) { transpose_item(P.in[11] + (size_t)l * D * FF, D, FF, wl + L_UP2, 2, scr, r, lane, gl + 4 * D); continue; } r -= I_G;
        transpose_item(P.in[12] + (size_t)l * D * FF, FF, D, wl + L_DN2, 0, scr, r, lane, nullptr);
    }
    for (int v = gtid; v < DEPTH * 16384; v += nthr) { const int l = v / 16384, o = v % 16384;
        *(u32x4*)(WB + (size_t)l * L_ELEMS + L_IN + (size_t)NIN * D + (size_t)o * 8) = (u32x4){0u, 0u, 0u, 0u}; }
}

constexpr int RP = 4, XP = 2048;
__device__ __forceinline__ void row_pass(const bf16_t* OB, const float* x32, bf16_t* X16, float* RS, float* out32, const float* gpost, float cres, int rows, int gw, int ngw, int lane) {
    f32x4 gpo[4];
#pragma unroll
    for (int j = 0; j < 4; ++j) gpo[j] = OB ? ((const f32x4*)gpost)[lane + 64 * j] : (f32x4){0.f, 0.f, 0.f, 0.f};
    for (int row0 = gw; row0 < rows; row0 += RP * ngw) {
        f32x4 xv[RP][4]; u32x2 ow[RP][4];
#pragma unroll
        for (int k = 0; k < RP; ++k) { const size_t row = (size_t)row0 + (size_t)k * ngw;
            if (x32) { const f32x4* xr = (const f32x4*)(x32 + row * D) + lane;
#pragma unroll
                for (int j = 0; j < 4; ++j) xv[k][j] = __builtin_nontemporal_load(xr + 64 * j); }
            else { const u32x2* xr = (const u32x2*)(X16 + row * XP) + lane;
#pragma unroll
                for (int j = 0; j < 4; ++j) { const u32x2 w = xr[64 * j]; xv[k][j] = (f32x4){bf_lo(w.x), bf_hi(w.x), bf_lo(w.y), bf_hi(w.y)}; }
                const float ri = RS[row];
#pragma unroll
                for (int j = 0; j < 4; ++j) xv[k][j] = xv[k][j] * ri; }
            if (OB) { const u32x2* orow = (const u32x2*)(OB + row * D) + lane;
#pragma unroll
                for (int j = 0; j < 4; ++j) ow[k][j] = __builtin_nontemporal_load(orow + 64 * j); } }
        if (OB) {
            float ss[RP];
#pragma unroll
            for (int k = 0; k < RP; ++k) { ss[k] = 0.f;
#pragma unroll
                for (int j = 0; j < 4; ++j) { const float a = bf_lo(ow[k][j].x), b = bf_hi(ow[k][j].x), c = bf_lo(ow[k][j].y), d = bf_hi(ow[k][j].y); ss[k] += (a * a + b * b) + (c * c + d * d); } }
#pragma unroll
            for (int k = 0; k < RP; ++k) ss[k] += shx<1>(ss[k], lane);
#pragma unroll
            for (int k = 0; k < RP; ++k) ss[k] += shx<2>(ss[k], lane);
#pragma unroll
            for (int k = 0; k < RP; ++k) ss[k] += shx<4>(ss[k], lane);
#pragma unroll
            for (int k = 0; k < RP; ++k) ss[k] += shx<8>(ss[k], lane);
#pragma unroll
            for (int k = 0; k < RP; ++k) ss[k] += shx<16>(ss[k], lane);
#pragma unroll
            for (int k = 0; k < RP; ++k) ss[k] += shx<32>(ss[k], lane);
#pragma unroll
            for (int k = 0; k < RP; ++k) { const float rs = rsqrtf(ss[k] * (1.f / D) + EPS) * cres;
#pragma unroll
                for (int j = 0; j < 4; ++j) { const f32x4 ov = (f32x4){bf_lo(ow[k][j].x), bf_hi(ow[k][j].x), bf_lo(ow[k][j].y), bf_hi(ow[k][j].y)};
                    xv[k][j] = xv[k][j] + ov * gpo[j] * rs; } }
        }
        if (out32) {
#pragma unroll
            for (int k = 0; k < RP; ++k) { const size_t row = (size_t)row0 + (size_t)k * ngw; f32x4* xo = (f32x4*)(out32 + row * D) + lane;
#pragma unroll
                for (int j = 0; j < 4; ++j) xo[64 * j] = xv[k][j]; }
        } else {
            float ss[RP];
#pragma unroll
            for (int k = 0; k < RP; ++k) { ss[k] = 0.f;
#pragma unroll
                for (int j = 0; j < 4; ++j) ss[k] += (xv[k][j].x * xv[k][j].x + xv[k][j].y * xv[k][j].y) + (xv[k][j].z * xv[k][j].z + xv[k][j].w * xv[k][j].w); }
#pragma unroll
            for (int k = 0; k < RP; ++k) ss[k] += shx<1>(ss[k], lane);
#pragma unroll
            for (int k = 0; k < RP; ++k) ss[k] += shx<2>(ss[k], lane);
#pragma unroll
            for (int k = 0; k < RP; ++k) ss[k] += shx<4>(ss[k], lane);
#pragma unroll
            for (int k = 0; k < RP; ++k) ss[k] += shx<8>(ss[k], lane);
#pragma unroll
            for (int k = 0; k < RP; ++k) ss[k] += shx<16>(ss[k], lane);
#pragma unroll
            for (int k = 0; k < RP; ++k) ss[k] += shx<32>(ss[k], lane);
#pragma unroll
            for (int k = 0; k < RP; ++k) { const size_t row = (size_t)row0 + (size_t)k * ngw;
                const float ms = ss[k] * (1.f / D) + EPS, rs = rsqrtf(ms);
                if (lane == 0) RS[row] = ms * rs;
                u32x2* ao = (u32x2*)(X16 + row * XP) + lane;
#pragma unroll
                for (int j = 0; j < 4; ++j) { const f32x4 v = xv[k][j] * rs; u32x2 w; w.x = cvt_pk_bf16(v.x, v.y); w.y = cvt_pk_bf16(v.z, v.w); ao[64 * j] = w; } }
        }
    }
}

constexpr int AK_PITCH = 144, AV_PITCH = 528, AK_BYTES = 256 * AK_PITCH;
struct AttnStage { u32x4 k[4], v[4]; bf16x8 q[2]; };
__device__ __forceinline__ AttnStage attn_load(const bf16_t* Z, int S, int it, int tid, int wave, int lane) {
    AttnStage st;
    const int p = it / 1536, rem = it % 1536, h = rem / 256, gb = rem % 256;
    const int bps = S >> 7, b = gb / bps, rb = gb % bps;
    const int dl = 2 * p, d = 1 << dl, L = S >> dl, nb = bps >> dl;
    const int r = rb / nb, lb = rb % nb, l0 = lb * 128;
    const int tok0 = b * S + r;
#pragma unroll
    for (int q = 0; q < 4; ++q) {
        const int idx = tid + 512 * q, i = idx >> 3, g = idx & 7, lk = l0 - 64 + i;
        st.k[q] = (u32x4){0u, 0u, 0u, 0u}; st.v[q] = (u32x4){0u, 0u, 0u, 0u};
        if (lk >= 0 && lk < L) { const bf16_t* zr = Z + ZA_OFF + ((size_t)h * TH + (size_t)(tok0 + lk * d)) * 192 + g * 8;
            st.k[q] = *(const u32x4*)(zr + 64); st.v[q] = *(const u32x4*)(zr + 128); }
    }
    const int fr = lane & 15, fq = lane >> 4;
    const size_t tq = (size_t)(tok0 + (l0 + 16 * wave + fr) * d);
#pragma unroll
    for (int kc = 0; kc < 2; ++kc) st.q[kc] = *(const bf16x8*)(Z + ZA_OFF + ((size_t)h * TH + tq) * 192 + kc * 32 + fq * 8);
    return st;
}
__device__ __forceinline__ AttnStage attn_item(LAS unsigned char* lds, const bf16_t* Z, bf16_t* PO, float* LSE, int S, int it, int itn, const AttnStage st, int tid, int wave, int lane) {
    const int p = it / 1536, rem = it % 1536, h = rem / 256, gb = rem % 256;
    const int bps = S >> 7, b = gb / bps, rb = gb % bps;
    const int dl = 2 * p, d = 1 << dl, L = S >> dl, nb = bps >> dl;
    const int r = rb / nb, lb = rb % nb, l0 = lb * 128;
    const int tok0 = b * S + r;
    LAS unsigned char* sK = lds; LAS unsigned char* sV = lds + AK_BYTES;
#pragma unroll
    for (int q = 0; q < 4; ++q) {
        const int idx = tid + 512 * q, i = idx >> 3, g = idx & 7;
        const u32x4 kv = st.k[q], vv = st.v[q];
        *(LAS u32x4*)(sK + i * AK_PITCH + g * 16) = kv;
        LAS bf16_t* vt = (LAS bf16_t*)(sV + (g * 8) * AV_PITCH + i * 2);
        vt[0 * (AV_PITCH / 2)] = (bf16_t)(vv.x & 0xffffu); vt[1 * (AV_PITCH / 2)] = (bf16_t)(vv.x >> 16);
        vt[2 * (AV_PITCH / 2)] = (bf16_t)(vv.y & 0xffffu); vt[3 * (AV_PITCH / 2)] = (bf16_t)(vv.y >> 16);
        vt[4 * (AV_PITCH / 2)] = (bf16_t)(vv.z & 0xffffu); vt[5 * (AV_PITCH / 2)] = (bf16_t)(vv.z >> 16);
        vt[6 * (AV_PITCH / 2)] = (bf16_t)(vv.w & 0xffffu); vt[7 * (AV_PITCH / 2)] = (bf16_t)(vv.w >> 16);
    }
    bf16x8 qf[2]; qf[0] = st.q[0]; qf[1] = st.q[1];
    __syncthreads();
    const AttnStage nst = attn_load(Z, S, itn, tid, wave, lane);
    const int fr = lane & 15, fq = lane >> 4;
    const int lq = l0 + 16 * wave + fr;
    const size_t tq = (size_t)(tok0 + lq * d);
    f32x4 s[9];
    __builtin_amdgcn_s_setprio(1);
#pragma unroll
    for (int kt = 0; kt < 9; ++kt) { s[kt] = (f32x4){0.f, 0.f, 0.f, 0.f};
#pragma unroll
        for (int kc = 0; kc < 2; ++kc) { const bf16x8 a = *(const LAS bf16x8*)(sK + (16 * wave + kt * 16 + fr) * AK_PITCH + (kc * 32 + fq * 8) * 2);
            s[kt] = __builtin_amdgcn_mfma_f32_16x16x32_bf16(a, qf[kc], s[kt], 0, 0, 0); } }
    __builtin_amdgcn_s_setprio(0);
    const float slope = (h == 0) ? 0.25f : (h == 1) ? 0.0625f : (h == 2) ? 0.015625f : (h == 3) ? 0.00390625f : (h == 4) ? 0.5f : 0.125f;
    const float c1 = 0.125f * LOG2E, c2 = slope * (float)d * LOG2E;
    float mx = -1e30f;
#pragma unroll
    for (int kt = 0; kt < 9; ++kt)
#pragma unroll
        for (int j = 0; j < 4; ++j) { const int ki = kt * 16 + fq * 4 + j; const int rel = ki - 64 - fr; const int ar = rel < 0 ? -rel : rel; const int lk = l0 - 64 + 16 * wave + ki;
            const bool valid = (ar <= 64) && (lk >= 0) && (lk < L);
            const float v = valid ? (s[kt][j] * c1 - c2 * (float)ar) : -1e30f; s[kt][j] = v; mx = fmaxf(mx, v); }
    mx = fmaxf(mx, shx<16>(mx, lane)); mx = fmaxf(mx, shx<32>(mx, lane));
    float sum = 0.f; bf16x4 pf[9];
#pragma unroll
    for (int kt = 0; kt < 9; ++kt) { float e[4];
#pragma unroll
        for (int j = 0; j < 4; ++j) { e[j] = fexp2(s[kt][j] - mx); sum += e[j]; }
        const unsigned w0 = cvt_pk_bf16(e[0], e[1]), w1 = cvt_pk_bf16(e[2], e[3]);
        pf[kt] = (bf16x4){(short)(w0 & 0xffffu), (short)(w0 >> 16), (short)(w1 & 0xffffu), (short)(w1 >> 16)}; }
    sum += shx<16>(sum, lane); sum += shx<32>(sum, lane);
    f32x4 o[4];
#pragma unroll
    for (int dt = 0; dt < 4; ++dt) o[dt] = (f32x4){0.f, 0.f, 0.f, 0.f};
    __builtin_amdgcn_s_setprio(1);
#pragma unroll
    for (int kt = 0; kt < 9; ++kt)
#pragma unroll
        for (int dt = 0; dt < 4; ++dt) { const bf16x4 a = *(const LAS bf16x4*)(sV + (dt * 16 + fr) * AV_PITCH + (16 * wave + kt * 16 + fq * 4) * 2);
            o[dt] = __builtin_amdgcn_mfma_f32_16x16x16bf16_1k(a, pf[kt], o[dt], 0, 0, 0); }
    __builtin_amdgcn_s_setprio(0);
    const float inv = __builtin_amdgcn_rcpf(sum);
    bf16_t* po = PO + tq * 384 + h * 64 + fq * 4;
#pragma unroll
    for (int dt = 0; dt < 4; ++dt) { u32x2 w; w.x = cvt_pk_bf16(o[dt][0] * inv, o[dt][1] * inv); w.y = cvt_pk_bf16(o[dt][2] * inv, o[dt][3] * inv); *(u32x2*)(po + dt * 16) = w; }
    if (fq == 0) LSE[tq * 6 + h] = mx + __log2f(sum);
    __syncthreads();
    return nst;
}

constexpr int RT_PITCH = 272;
constexpr int RK_PITCH = 208;
__device__ __forceinline__ void retkv_item(LAS unsigned char* lds, const bf16_t* Z, bf16_t* ST, int it, float lgf2, float lgb2, int tid, int wave, int lane) {
    const int gc = it >> 2, h = it & 3;
    const size_t t0 = (size_t)gc * 128;
    LAS unsigned char* sKf = lds; LAS unsigned char* sKb = lds + 96 * RT_PITCH; LAS unsigned char* sV = lds + 2 * 96 * RT_PITCH;
    const float ksc = 0.10206207261596577f;
#pragma unroll
    for (int q = 0; q < 3; ++q) {
        const int idx = tid + 512 * q, m = idx / 12, g = idx % 12;
        const bf16_t* zr = Z + ZR_OFF + ((size_t)h * TH + t0 + m) * 384 + g * 8;
        const u32x4 kv = *(const u32x4*)(zr + 96), vv = *(const u32x4*)(zr + 192);
        const float wf = fexp2(lgf2 * (float)(127 - m)) * ksc, wb = fexp2(lgb2 * (float)m) * ksc;
        const unsigned kw[4] = {kv.x, kv.y, kv.z, kv.w}, vw[4] = {vv.x, vv.y, vv.z, vv.w};
#pragma unroll
        for (int e2 = 0; e2 < 4; ++e2) {
            const float k0 = bf_lo(kw[e2]), k1 = bf_hi(kw[e2]);
            const unsigned pfw = cvt_pk_bf16(k0 * wf, k1 * wf), pbw = cvt_pk_bf16(k0 * wb, k1 * wb);
            const int ro = (g * 8 + 2 * e2) * RT_PITCH + m * 2;
            *(LAS bf16_t*)(sKf + ro) = (bf16_t)(pfw & 0xffffu); *(LAS bf16_t*)(sKf + ro + RT_PITCH) = (bf16_t)(pfw >> 16);
            *(LAS bf16_t*)(sKb + ro) = (bf16_t)(pbw & 0xffffu); *(LAS bf16_t*)(sKb + ro + RT_PITCH) = (bf16_t)(pbw >> 16);
            *(LAS bf16_t*)(sV + ro) = (bf16_t)(vw[e2] & 0xffffu); *(LAS bf16_t*)(sV + ro + RT_PITCH) = (bf16_t)(vw[e2] >> 16);
        }
    }
    __syncthreads();
    const int fr = lane & 15, fq = lane >> 4;
    bf16_t* stb = ST + (size_t)it * 2 * 9216;
    for (int tt = wave * 9; tt < wave * 9 + 9; ++tt) {
        const int dir = tt / 36, rm = tt % 36, dt = rm / 6, et = rm % 6;
        LAS unsigned char* sK = dir ? sKb : sKf;
        f32x4 acc = (f32x4){0.f, 0.f, 0.f, 0.f};
#pragma unroll
        for (int ks = 0; ks < 4; ++ks) {
            const bf16x8 a = *(const LAS bf16x8*)(sK + (dt * 16 + fr) * RT_PITCH + (ks * 32 + fq * 8) * 2);
            const bf16x8 bb = *(const LAS bf16x8*)(sV + (et * 16 + fr) * RT_PITCH + (ks * 32 + fq * 8) * 2);
            acc = __builtin_amdgcn_mfma_f32_16x16x32_bf16(a, bb, acc, 0, 0, 0);
        }
        asm volatile("s_nop 7\n\ts_nop 7\n\ts_nop 7" : "+v"(acc));
        u32x2 w; w.x = cvt_pk_bf16(acc[0], acc[1]); w.y = cvt_pk_bf16(acc[2], acc[3]);
        __hip_atomic_store((unsigned long long*)(stb + (size_t)dir * 9216 + (et * 16 + fr) * 96 + dt * 16 + fq * 4), (unsigned long long)w.x | ((unsigned long long)w.y << 32), __ATOMIC_RELAXED, __HIP_MEMORY_SCOPE_AGENT);
    }
    __syncthreads();
}

__device__ __forceinline__ void ret_scan(bf16_t* ST, int S, volatile LAS float* lg2, int gtid, int nthr) {
    const int nc = S >> 7, nseq = TH / S, nvec = nseq * 4 * 2 * 1152;
    for (int v = gtid; v < nvec; v += nthr) {
        const int dv = v % 1152, t2 = v / 1152, dir = t2 & 1, h = (t2 >> 1) & 3, b = t2 >> 3;
        const float gC = fexp2(lg2[dir * 4 + h] * 128.f);
        float s[8];
#pragma unroll
        for (int k = 0; k < 8; ++k) s[k] = 0.f;
        for (int i0 = 0; i0 < nc; i0 += 16) {
            u32x4 t[16];
#pragma unroll
            for (int k = 0; k < 16; ++k) { const int i = i0 + k, c = dir ? nc - 1 - i : i;
                t[k] = *(const u32x4*)(ST + ((((size_t)(b * nc + c) * 4 + h) * 2 + dir) * 9216 + dv * 8)); }
#pragma unroll
            for (int k = 0; k < 16; ++k) { const int i = i0 + k, c = dir ? nc - 1 - i : i;
                u32x4 o; o.x = cvt_pk_bf16(s[0], s[1]); o.y = cvt_pk_bf16(s[2], s[3]); o.z = cvt_pk_bf16(s[4], s[5]); o.w = cvt_pk_bf16(s[6], s[7]);
                *(u32x4*)(ST + ((((size_t)(b * nc + c) * 4 + h) * 2 + dir) * 9216 + dv * 8)) = o;
                s[0] = gC * s[0] + bf_lo(t[k].x); s[1] = gC * s[1] + bf_hi(t[k].x); s[2] = gC * s[2] + bf_lo(t[k].y); s[3] = gC * s[3] + bf_hi(t[k].y);
                s[4] = gC * s[4] + bf_lo(t[k].z); s[5] = gC * s[5] + bf_hi(t[k].z); s[6] = gC * s[6] + bf_lo(t[k].w); s[7] = gC * s[7] + bf_hi(t[k].w); }
        }
    }
}

__device__ __forceinline__ void retout_item(LAS unsigned char* lds, const bf16_t* Z, const bf16_t* ST, bf16_t* YA, int it, float lgf2, float lgb2, int tid, int wave, int lane) {
    const int gc = it >> 2, h = it & 3;
    const size_t t0 = (size_t)gc * 128;
    LAS unsigned char* sK = lds; LAS unsigned char* sV = lds + 128 * RK_PITCH; LAS unsigned char* sS = sV + 96 * RT_PITCH;
    const bf16_t* stb = ST + (size_t)it * 2 * 9216;
#pragma unroll
    for (int q = 0; q < 5; ++q) { const int c = tid + 512 * q;
        if (c < 2304) { const int dir = c / 1152, rm = c % 1152, e = rm / 12, part = rm % 12;
            *(LAS u32x4*)(sS + (dir * 96 + e) * RK_PITCH + part * 16) = *(const u32x4*)(stb + (size_t)c * 8); } }
#pragma unroll
    for (int q = 0; q < 3; ++q) {
        const int idx = tid + 512 * q, m = idx / 12, g = idx % 12;
        const bf16_t* zr = Z + ZR_OFF + ((size_t)h * TH + t0 + m) * 384 + g * 8;
        const u32x4 kv = *(const u32x4*)(zr + 96), vv = *(const u32x4*)(zr + 192);
        *(LAS u32x4*)(sK + m * RK_PITCH + g * 16) = kv;
        const unsigned vw[4] = {vv.x, vv.y, vv.z, vv.w};
#pragma unroll
        for (int e2 = 0; e2 < 4; ++e2) { const int ro = (g * 8 + 2 * e2) * RT_PITCH + m * 2;
            *(LAS bf16_t*)(sV + ro) = (bf16_t)(vw[e2] & 0xffffu); *(LAS bf16_t*)(sV + ro + RT_PITCH) = (bf16_t)(vw[e2] >> 16); }
    }
    __syncthreads();
    const int fr = lane & 15, fq = lane >> 4;
    const int n = 16 * wave + fr;
    const size_t tq = t0 + n;
    const float ksc = 0.10206207261596577f;
    bf16x8 qf[3];
#pragma unroll
    for (int ks = 0; ks < 3; ++ks) qf[ks] = *(const bf16x8*)(Z + ZR_OFF + ((size_t)h * TH + tq) * 384 + ks * 32 + fq * 8);
    f32x4 o[6];
#pragma unroll
    for (int et = 0; et < 6; ++et) o[et] = (f32x4){0.f, 0.f, 0.f, 0.f};
#pragma unroll
    for (int mt = 0; mt < 8; ++mt) {
        f32x4 s = (f32x4){0.f, 0.f, 0.f, 0.f};
#pragma unroll
        for (int ks = 0; ks < 3; ++ks) { const bf16x8 a = *(const LAS bf16x8*)(sK + (mt * 16 + fr) * RK_PITCH + (ks * 32 + fq * 8) * 2);
            s = __builtin_amdgcn_mfma_f32_16x16x32_bf16(a, qf[ks], s, 0, 0, 0); }
        float pv[4];
#pragma unroll
        for (int j = 0; j < 4; ++j) { const int mm = mt * 16 + fq * 4 + j; const int df = n - mm;
            const float dec = (df >= 0) ? fexp2(lgf2 * (float)df) : fexp2(lgb2 * (float)(-df));
            pv[j] = s[j] * ksc * dec; }
        const unsigned w0 = cvt_pk_bf16(pv[0], pv[1]), w1 = cvt_pk_bf16(pv[2], pv[3]);
        const bf16x4 pfr = (bf16x4){(short)(w0 & 0xffffu), (short)(w0 >> 16), (short)(w1 & 0xffffu), (short)(w1 >> 16)};
#pragma unroll
        for (int et = 0; et < 6; ++et) { const bf16x4 a = *(const LAS bf16x4*)(sV + (et * 16 + fr) * RT_PITCH + (mt * 16 + fq * 4) * 2);
            o[et] = __builtin_amdgcn_mfma_f32_16x16x16bf16_1k(a, pfr, o[et], 0, 0, 0); }
    }
    const float qwf = fexp2(lgf2 * (float)(n + 1)), qwb = fexp2(lgb2 * (float)(128 - n));
#pragma unroll
    for (int dir = 0; dir < 2; ++dir) {
        const float qw = dir ? qwb : qwf;
#pragma unroll
        for (int et = 0; et < 6; ++et) {
            f32x4 x = (f32x4){0.f, 0.f, 0.f, 0.f};
#pragma unroll
            for (int ks = 0; ks < 3; ++ks) { const bf16x8 a = *(const LAS bf16x8*)(sS + (dir * 96 + et * 16 + fr) * RK_PITCH + (ks * 32 + fq * 8) * 2);
                x = __builtin_amdgcn_mfma_f32_16x16x32_bf16(a, qf[ks], x, 0, 0, 0); }
#ifndef DBG_NOCROSS
            o[et] = o[et] + x * qw;
#endif
        }
    }
#ifdef DBG_SANITIZE
#pragma unroll
    for (int et = 0; et < 6; ++et)
#pragma unroll
        for (int j = 0; j < 4; ++j) o[et][j] = (fabsf(o[et][j]) < 1e30f) ? o[et][j] : 0.f;
#endif
    float sm = 0.f;
#pragma unroll
    for (int et = 0; et < 6; ++et) sm += (o[et][0] + o[et][1]) + (o[et][2] + o[et][3]);
    sm += shx<16>(sm, lane); sm += shx<32>(sm, lane);
    const float mu = sm * (1.f / 96.f);
    float sq = 0.f;
#pragma unroll
    for (int et = 0; et < 6; ++et)
#pragma unroll
        for (int j = 0; j < 4; ++j) { const float dd = o[et][j] - mu; o[et][j] = dd; sq += dd * dd; }
    sq += shx<16>(sq, lane); sq += shx<32>(sq, lane);
    const float rs = rsqrtf(sq * (1.f / 96.f) + EPS);
#pragma unroll
    for (int et = 0; et < 6; ++et) {
        const u32x2 gw = *(const u32x2*)(Z + ZR_OFF + ((size_t)h * TH + tq) * 384 + 288 + et * 16 + fq * 4);
        const float g4[4] = {bf_lo(gw.x), bf_hi(gw.x), bf_lo(gw.y), bf_hi(gw.y)};
        float y[4];
#pragma unroll
        for (int j = 0; j < 4; ++j) { const float gg = g4[j]; y[j] = o[et][j] * rs * (gg * __builtin_amdgcn_rcpf(1.0f + __expf(-gg))); }
        u32x2 w; w.x = cvt_pk_bf16(y[0], y[1]); w.y = cvt_pk_bf16(y[2], y[3]);
#ifdef DBG_ZRET
        w.x = 0u; w.y = 0u;
#endif
        *(u32x2*)(YA + tq * D + 384 + h * 96 + et * 16 + fq * 4) = w;
    }
    __syncthreads();
}

struct MergeLd { float l0, l1, l2; u32x4 a, b, c; };
__device__ __forceinline__ MergeLd merge_load(const bf16_t* PO01, const bf16_t* PO2, const float* LSE, int it) {
    const int tok = it / 48, grp = it % 48, h = grp >> 3; MergeLd m;
    m.l0 = LSE[(size_t)tok * 6 + h]; m.l1 = LSE[(size_t)TH * 6 + (size_t)tok * 6 + h]; m.l2 = LSE[(size_t)2 * TH * 6 + (size_t)tok * 6 + h];
    m.a = *(const u32x4*)(PO01 + (size_t)tok * 384 + grp * 8); m.b = *(const u32x4*)(PO01 + (size_t)TH * 384 + (size_t)tok * 384 + grp * 8); m.c = *(const u32x4*)(PO2 + (size_t)tok * 384 + grp * 8);
    return m;
}
__device__ __forceinline__ void merge_store(const MergeLd& m, bf16_t* YA, int it) {
    const int tok = it / 48, grp = it % 48;
    const float M = fmaxf(m.l0, fmaxf(m.l1, m.l2));
    float w0 = fexp2(m.l0 - M), w1 = fexp2(m.l1 - M), w2 = fexp2(m.l2 - M);
    const float inv = __builtin_amdgcn_rcpf(w0 + w1 + w2); w0 *= inv; w1 *= inv; w2 *= inv;
    const u32x4 a = m.a, b = m.b, c = m.c; u32x4 o;
    o.x = cvt_pk_bf16(w0 * bf_lo(a.x) + w1 * bf_lo(b.x) + w2 * bf_lo(c.x), w0 * bf_hi(a.x) + w1 * bf_hi(b.x) + w2 * bf_hi(c.x));
    o.y = cvt_pk_bf16(w0 * bf_lo(a.y) + w1 * bf_lo(b.y) + w2 * bf_lo(c.y), w0 * bf_hi(a.y) + w1 * bf_hi(b.y) + w2 * bf_hi(c.y));
    o.z = cvt_pk_bf16(w0 * bf_lo(a.z) + w1 * bf_lo(b.z) + w2 * bf_lo(c.z), w0 * bf_hi(a.z) + w1 * bf_hi(b.z) + w2 * bf_hi(c.z));
    o.w = cvt_pk_bf16(w0 * bf_lo(a.w) + w1 * bf_lo(b.w) + w2 * bf_lo(c.w), w0 * bf_hi(a.w) + w1 * bf_hi(b.w) + w2 * bf_hi(c.w));
#ifdef DBG_ZATT
    o = (u32x4){0u, 0u, 0u, 0u};
#endif
    *(u32x4*)(YA + (size_t)tok * D + grp * 8) = o;
}
struct ConvLd { u32x4 bc, cc0, uc0, cc1, uc1, cc2, uc2; };
__device__ __forceinline__ ConvLd conv_load(const bf16_t* Z, int S, int it) {
    const int tok = it >> 5, ch0 = (it & 31) * 8, pos = tok % S; ConvLd v;
    const bf16_t* zr = Z + ZC_OFF + (size_t)tok * 768;
    v.bc = *(const u32x4*)(zr + ch0); v.cc1 = *(const u32x4*)(zr + 256 + ch0); v.uc1 = *(const u32x4*)(zr + 512 + ch0);
    v.cc0 = (u32x4){0u, 0u, 0u, 0u}; v.uc0 = v.cc0; v.cc2 = v.cc0; v.uc2 = v.cc0;
    if (pos > 0) { v.cc0 = *(const u32x4*)(zr - 768 + 256 + ch0); v.uc0 = *(const u32x4*)(zr - 768 + 512 + ch0); }
    if (pos < S - 1) { v.cc2 = *(const u32x4*)(zr + 768 + 256 + ch0); v.uc2 = *(const u32x4*)(zr + 768 + 512 + ch0); }
    return v;
}
__device__ __forceinline__ void conv_store(const ConvLd& v, const float* convw, bf16_t* YA, int it) {
    const int tok = it >> 5, ch0 = (it & 31) * 8;
    const unsigned B[4] = {v.bc.x, v.bc.y, v.bc.z, v.bc.w}, C0[4] = {v.cc0.x, v.cc0.y, v.cc0.z, v.cc0.w}, U0[4] = {v.uc0.x, v.uc0.y, v.uc0.z, v.uc0.w},
                   C1[4] = {v.cc1.x, v.cc1.y, v.cc1.z, v.cc1.w}, U1[4] = {v.uc1.x, v.uc1.y, v.uc1.z, v.uc1.w}, C2[4] = {v.cc2.x, v.cc2.y, v.cc2.z, v.cc2.w}, U2[4] = {v.uc2.x, v.uc2.y, v.uc2.z, v.uc2.w};
    const f32x4 wa0 = *(const f32x4*)(convw + ch0), wa1 = *(const f32x4*)(convw + ch0 + 4), wb0 = *(const f32x4*)(convw + 256 + ch0), wb1 = *(const f32x4*)(convw + 256 + ch0 + 4),
                wc0 = *(const f32x4*)(convw + 512 + ch0), wc1 = *(const f32x4*)(convw + 512 + ch0 + 4);
    const float W0[8] = {wa0.x, wa0.y, wa0.z, wa0.w, wa1.x, wa1.y, wa1.z, wa1.w}, W1[8] = {wb0.x, wb0.y, wb0.z, wb0.w, wb1.x, wb1.y, wb1.z, wb1.w}, W2[8] = {wc0.x, wc0.y, wc0.z, wc0.w, wc1.x, wc1.y, wc1.z, wc1.w};
    unsigned ow[4];
#pragma unroll
    for (int e2 = 0; e2 < 4; ++e2) {
        const float a0 = bf_lo(C0[e2]) * bf_lo(U0[e2]) * W0[2 * e2] + bf_lo(C1[e2]) * bf_lo(U1[e2]) * W1[2 * e2] + bf_lo(C2[e2]) * bf_lo(U2[e2]) * W2[2 * e2];
        const float a1 = bf_hi(C0[e2]) * bf_hi(U0[e2]) * W0[2 * e2 + 1] + bf_hi(C1[e2]) * bf_hi(U1[e2]) * W1[2 * e2 + 1] + bf_hi(C2[e2]) * bf_hi(U2[e2]) * W2[2 * e2 + 1];
        ow[e2] = cvt_pk_bf16(bf_lo(B[e2]) * a0, bf_hi(B[e2]) * a1);
    }
#ifdef DBG_ZCONV
    ow[0] = ow[1] = ow[2] = ow[3] = 0u;
#endif
    *(u32x4*)(YA + (size_t)tok * D + 768 + ch0) = (u32x4){ow[0], ow[1], ow[2], ow[3]};
}
__device__ __forceinline__ void merge_conv(const bf16_t* Z, const bf16_t* PO01, const bf16_t* PO2, const float* LSE, const float* convw, bf16_t* YA, int S, int gtid, int nthr) {
    for (int it = gtid; it < TH * 48; it += 2 * nthr) {
        const int it2 = it + nthr; const bool two = it2 < TH * 48;
        const MergeLd m0 = merge_load(PO01, PO2, LSE, it); MergeLd m1 = m0; if (two) m1 = merge_load(PO01, PO2, LSE, it2);
        merge_store(m0, YA, it); if (two) merge_store(m1, YA, it2);
    }
    for (int it = gtid; it < TH * 32; it += 2 * nthr) {
        const int it2 = it + nthr; const bool two = it2 < TH * 32;
        const ConvLd c0 = conv_load(Z, S, it); ConvLd c1 = c0; if (two) c1 = conv_load(Z, S, it2);
        conv_store(c0, convw, YA, it); if (two) conv_store(c1, convw, YA, it2);
    }
}

#define XB_TMO      128
#define XB_XCNT(j)  (256  + 64 * (j))
#define XB_XSUB(j)  (1280 + 64 * (j))
#define XB_XGEN(j)  (2304 + 64 * (j))
#define XB_TOP      3328
#define XB_TOPGEN   3392
#define XCD_BAR_WORDS 3456
#define XB_SPIN_CAP (1u << 22)
__device__ __forceinline__ unsigned xb_ld(unsigned* p)              { return __hip_atomic_load(p, __ATOMIC_RELAXED, __HIP_MEMORY_SCOPE_AGENT); }
__device__ __forceinline__ unsigned xb_add(unsigned* p, unsigned v) { return __hip_atomic_fetch_add(p, v, __ATOMIC_RELAXED, __HIP_MEMORY_SCOPE_AGENT); }
__device__ __forceinline__ unsigned xb_xcc_id() { return (unsigned)__builtin_amdgcn_s_getreg((3 << 11) | 20) & 0xFu; }
#define XB_SPIN(cond, bar) do { unsigned _sp = 0; while (cond) { __builtin_amdgcn_s_sleep(16); \
    if ((++_sp & 255u) == 0u) { if (xb_ld(&(bar)[XB_TMO])) break; if (_sp > XB_SPIN_CAP) { atomicAdd(&(bar)[XB_TMO], 1u); break; } } } } while (0)
struct XcdBarrier { unsigned* bar; unsigned x; volatile LAS unsigned* st; };
__device__ __forceinline__ XcdBarrier xcd_barrier_post(unsigned* bar, volatile LAS unsigned* st) {
    XcdBarrier b; b.bar = bar; b.x = xb_xcc_id(); b.st = st;
    if (threadIdx.x == 0) (void)xb_add(&bar[XB_XCNT(b.x)], 1u);
    return b;
}
__device__ __forceinline__ void xcd_barrier_complete(unsigned* bar, unsigned x, unsigned& nloc, unsigned& nx) {
    const unsigned G = gridDim.x * gridDim.y * gridDim.z;
    unsigned sum, cnt, mine, sp = 0u;
    for (;;) {
        sum = 0u; cnt = 0u; mine = 0u;
#pragma unroll
        for (unsigned j = 0; j < 16; ++j) { const unsigned c = xb_ld(&bar[XB_XCNT(j)]); sum += c; cnt += (c > 0u) ? 1u : 0u; mine = (j == x) ? c : mine; }
        if (sum == G) break;
        __builtin_amdgcn_s_sleep(1);
        if ((++sp & 255u) == 0u) { if (xb_ld(&bar[XB_TMO])) break; if (sp > XB_SPIN_CAP) { atomicAdd(&bar[XB_TMO], 1u); break; } }
    }
    nloc = mine > 0u ? mine : 1u; nx = cnt > 0u ? cnt : 1u;
}
__device__ __forceinline__ void xcd_barrier(const XcdBarrier& b) {
    asm volatile("s_waitcnt vmcnt(0)" ::: "memory");
    __syncthreads();
    if (threadIdx.x == 0) {
        unsigned* bar = b.bar; asm volatile("" : "+s"(bar));
        unsigned bxx = b.x; asm volatile("" : "+s"(bxx));
        __builtin_amdgcn_s_waitcnt(0);
        unsigned nloc = b.st[0], nx = b.st[1];
        if (nloc == 0u) { xcd_barrier_complete(bar, bxx, nloc, nx); b.st[0] = nloc; b.st[1] = nx; }
        const unsigned old = xb_add(&bar[XB_XSUB(bxx)], 1u);
        const unsigned gen = old / nloc;
        if (old + 1u == (gen + 1u) * nloc) {
            __builtin_amdgcn_fence(__ATOMIC_RELEASE, "agent");
            asm volatile("s_waitcnt vmcnt(0)" ::: "memory");
            const unsigned og = xb_add(&bar[XB_TOP], 1u);
            const unsigned tg = og / nx;
            if (og + 1u == (tg + 1u) * nx) xb_add(&bar[XB_TOPGEN], 1u);
            else XB_SPIN(xb_ld(&bar[XB_TOPGEN]) == tg, bar);
            __builtin_amdgcn_fence(__ATOMIC_ACQUIRE, "agent");
            xb_add(&bar[XB_XGEN(bxx)], 1u);
            asm volatile("s_waitcnt vmcnt(0)" ::: "memory");
        } else {
            XB_SPIN(xb_ld(&bar[XB_XGEN(bxx)]) == gen, bar);
            __builtin_amdgcn_fence(__ATOMIC_ACQUIRE, "agent");
            asm volatile("s_waitcnt vmcnt(0)" ::: "memory");
        }
    }
    __syncthreads();
}

__global__ void __launch_bounds__(512, 2) mega_fwd(Params P) {
    extern __shared__ __attribute__((aligned(16))) unsigned char lds_raw[];
    cg::grid_group grid = cg::this_grid();
    LAS unsigned char* lds = (LAS unsigned char*)lds_raw;
    const int tid0 = threadIdx.x, wave0 = __builtin_amdgcn_readfirstlane(tid0 >> 6);
    const int G = gridDim.x, bx0 = blockIdx.x;
    const int ngw = G * 8, nthr = G * 512;
    int wave = wave0, bx = bx0, gw = bx0 * 8 + wave0;
    unsigned char* ws0 = P.ws;
    unsigned char* ws = ws0;

    if (tid0 < 64) ((LAS unsigned*)(lds + LDS_STAGE))[tid0] = 0u;
    if (bx0 == 0) for (int wI = tid0; wI < 4096; wI += 512) __hip_atomic_store((unsigned*)(ws + WS_BAR) + wI, 0u, __ATOMIC_RELAXED, __HIP_MEMORY_SCOPE_AGENT);
    asm volatile("s_waitcnt vmcnt(0)" ::: "memory");
    __syncthreads();
    grid.sync();
    const XcdBarrier xbar = xcd_barrier_post((unsigned*)(ws + WS_BAR), (volatile LAS unsigned*)(lds + LDS_STAGE));
    for (int rep = 0; rep < NREP(5); ++rep) { __syncthreads(); phase_weights(P, lds, gw, ngw, wave, tid0 & 63, bx * 512 + tid0, nthr); }
    row_pass(nullptr, P.in[0], (bf16_t*)P.out + 1024, (float*)(ws + WS_RS), nullptr, nullptr, 0.f, TH, gw, ngw, tid0 & 63);
    xcd_barrier(xbar);

#if REP_MASK
    for (int st = 0; st < 100; ++st) {
      const int ph = st >> 1, rep = st & 1;
      if (rep) { const int q_ = ph % 25; int kind = 15;
          if (q_ == 0) kind = 6; else { const int r_ = (q_ - 1) % 12;
              kind = (r_ == 0 || r_ == 9) ? 0 : (r_ == 1 || r_ == 3 || r_ == 7 || r_ == 10) ? 1 : (r_ == 4) ? 2 : (r_ == 6) ? 3 : ((r_ == 2 || r_ == 8 || r_ == 11) && !(r_ == 11 && q_ > 12)) ? 4 : 15; }
          if (!((REP_MASK >> kind) & 1)) continue; }
      {
#else
    for (int ph = 0; ph < 50; ++ph) {
      const int rep = 0;
      {
#endif
        int wv = wave0; asm volatile("" : "+s"(wv));
        unsigned allm = ~0u; asm volatile("" : "+s"(allm));
        int tid = wv * 64 + (int)__builtin_amdgcn_mbcnt_hi(allm, __builtin_amdgcn_mbcnt_lo(allm, 0u)); asm volatile("" : "+v"(tid));
        unsigned char* ws = ws0; asm volatile("" : "+s"(ws));
        bf16_t* WB = (bf16_t*)(ws + WS_W);
        bf16_t* XA = (bf16_t*)(ws + WS_XA);
        bf16_t* OB = (bf16_t*)(ws + WS_OB);
        bf16_t* BIG = (bf16_t*)(ws + WS_BIG);
        bf16_t* ST = (bf16_t*)(ws + WS_ST);
        bf16_t* PO2 = (bf16_t*)(ws + WS_P2);
        float* LSE = (float*)(ws + WS_OB + OB_LSE_OFF);
        float* RS = (float*)(ws + WS_RS);
        const float* gains = P.in[2];
        int bx = bx0; asm volatile("" : "+s"(bx));
        const int wave = __builtin_amdgcn_readfirstlane(tid >> 6), gw = bx * 8 + wave;
        const int lane = tid & 63, gtid = bx * 512 + tid;
        const int hf = ph / 25, q = ph % 25;
        const int S = hf ? 4096 : 2048;
        const float* xin = P.in[hf];
        float* xout = P.out + (size_t)hf * TH * D;
        bf16_t* X16 = (bf16_t*)xout + 1024;
        if (q == 0) continue;
        {
            const int l = (q - 1) / 12, r = (q - 1) % 12;
            const bf16_t* wl = WB + (size_t)l * L_ELEMS;
            const float* gl = gains + (size_t)l * 6 * D;
            if (r == 0 || r == 9) {
                pg8::Gemm g{X16, wl + (r == 0 ? L_UP1 : L_UP2), TH, NUP, D, XP}; pg8::StaticOrder So; So.init(TH, NUP, G, bx);
                pg8::EpiSwiglu E{BIG, FF};
                pg8::gemm_phase<pg8::EpiSwiglu, true>(lds, g, So, E, tid);
            } else if (r == 1 || r == 3 || r == 7 || r == 10) {
                pg8::Gemm g; pg8::EpiStore E;
                if (r == 1 || r == 10) { g = pg8::Gemm{BIG, wl + (r == 1 ? L_DN1 : L_DN2), TH, D, FF, FF}; E = pg8::EpiStore{OB, D, D, nullptr}; }
                else if (r == 3) { g = pg8::Gemm{X16, wl + L_IN, TH, NINP, D, XP}; E = pg8::EpiStore{BIG, 0, NIN, nullptr}; }
                else { g = pg8::Gemm{XA, wl + L_OUT, TH, D, D, D}; E = pg8::EpiStore{OB, D, D, nullptr}; }
                pg8::StaticOrder So; So.init(TH, g.N, G, bx, r == 3);
                pg8::gemm_phase<pg8::EpiStore, true>(lds, g, So, E, tid);
            } else if (r == 2 || r == 8 || r == 11) {
                const float* gpost = gl + (r == 2 ? 1 : r == 8 ? 3 : 5) * D;
                const bool fin = (r == 11 && l + 1 == DEPTH);
                row_pass(OB, (l == 0 && r == 2 && rep == 0) ? xin : nullptr, X16, RS, fin ? xout : nullptr, gpost, rep ? 0.0f : ((r == 8) ? 1.0f : 0.5f), TH, gw, ngw, lane);
                if (fin && hf == 0) row_pass(nullptr, P.in[1], (bf16_t*)(P.out + (size_t)TH * D) + 1024, RS, nullptr, nullptr, 0.f, TH, gw, ngw, lane);
            } else {
                volatile LAS float* lgs = (volatile LAS float*)(lds + LDS_STAGE + 128);
                if (tid < 8) lgs[tid] = -__log2f(1.0f + __expf(-(P.in[8] + l * 8)[tid]));
                __syncthreads();
                if (r == 4) {
                    { AttnStage ast = attn_load(BIG, S, bx % 4608, tid, wave, lane);
                      for (int it = bx; it < 4608; it += G) {
                        const int p = it / 1536, itn = (it + G < 4608) ? it + G : it;
                        ast = attn_item(lds, BIG, (p < 2) ? OB + (size_t)p * TH * 384 : PO2, LSE + (size_t)p * TH * 6, S, it, itn, ast, tid, wave, lane);
                      } }
                    for (int it = bx; it < 1024; it += G) {
                        const int h = it & 3;
                        const float lgf2 = lgs[h], lgb2 = lgs[4 + h];
                        retkv_item(lds, BIG, ST, it, lgf2, lgb2, tid, wave, lane);
                    }
                } else if (r == 5) {
                    ret_scan(ST, S, lgs, gtid, nthr);
                    __syncthreads();
                } else {
                    for (int it = bx; it < 1024; it += G) {
                        const int h = it & 3;
                        const float lgf2 = lgs[h], lgb2 = lgs[4 + h];
                        retout_item(lds, BIG, ST, XA, it, lgf2, lgb2, tid, wave, lane);
                    }
                    merge_conv(BIG, OB, PO2, LSE, P.in[7] + l * 768, XA, S, gtid, nthr);
                }
            }
        }
      }
        for (int rp = 0; rp < NREP(7); ++rp) xcd_barrier(xbar);
    }
}

extern "C" void kernel_launch(void* const* d_in, const int* in_sizes, int n_in, void* d_out, int out_size, void* d_ws, size_t ws_size, hipStream_t stream) {
    static int grid = 0;
    if (grid == 0) {
        if (n_in != 13 || ws_size < WS_TOTAL) { fprintf(stderr, "kernel_launch: need 13 inputs and >= %zu bytes of workspace (got %d, %zu)\n", (size_t)WS_TOTAL, n_in, ws_size); grid = -1; return; }
        int dev = 0, cus = 0, per_cu = 0;
        hipGetDevice(&dev);
        hipDeviceGetAttribute(&cus, hipDeviceAttributeMultiprocessorCount, dev);
        hipFuncSetAttribute((const void*)mega_fwd, hipFuncAttributeMaxDynamicSharedMemorySize, LDS_BYTES);
        hipOccupancyMaxActiveBlocksPerMultiprocessor(&per_cu, (const void*)mega_fwd, 512, LDS_BYTES);
        if (per_cu < 1) per_cu = 1;
        grid = cus * per_cu;
        fprintf(stderr, "kernel_launch: grid %d (cus %d x %d)\n", grid, cus, per_cu);
    }
    if (grid < 0) return;
    Params p{};
    for (int i = 0; i < 13; ++i) p.in[i] = (const float*)d_in[i];
    p.out = (float*)d_out; p.ws = (unsigned char*)d_ws;
    void* args[] = {&p};
    hipError_t e = hipLaunchCooperativeKernel((const void*)mega_fwd, dim3(grid), dim3(512), args, LDS_BYTES, stream);
    if (e != hipSuccess) fprintf(stderr, "cooperative launch failed: %s (grid %d)\n", hipGetErrorString(e), grid);
}
```
